# Optimizing an MI355X kernel written in HIP

```python
import math
import jax, jax.numpy as jnp
from jax import lax
import numpy as np

D_MODEL = 4096
BATCH = 1
SEQ = 16384
DEPTH = 1
DEC_BATCH = 1
DEC_SEQ = 8192
PAST_LEN = 128

HEAD_DIM = 128
HEADS_PER_GROUP = 8
DILATED_GROUPS = ((128, 1), (512, 4), (2048, 16))
N_GROUPS = len(DILATED_GROUPS)
N_ATTN_HEADS = HEADS_PER_GROUP * N_GROUPS
ATTN_WIDTH = N_ATTN_HEADS * HEAD_DIM
ATTN_OUT_WIDTH = HEADS_PER_GROUP * HEAD_DIM
FOURIER_WIDTH = D_MODEL // 4
FOURIER_GROUPS = 4
FOURIER_GROUP_DIM = FOURIER_WIDTH // FOURIER_GROUPS
N_BRANCHES = 2
IN_WIDTH = 3 * ATTN_WIDTH + FOURIER_WIDTH + N_BRANCHES * D_MODEL
SPLIT_POINTS = (ATTN_WIDTH, 2 * ATTN_WIDTH, 3 * ATTN_WIDTH,
                3 * ATTN_WIDTH + FOURIER_WIDTH, 3 * ATTN_WIDTH + FOURIER_WIDTH + D_MODEL)
D_FF = -(-(8 * D_MODEL) // (3 * 256)) * 256
N_MOD = 6
ROPE_THETA = 10000.0
LN_EPS = 1e-5
NEG_INF = -1e30
DEEPNORM_ALPHA = (2.0 * DEPTH) ** 0.25
DEEPNORM_BETA = (8.0 * DEPTH) ** -0.25

kernel_name = 'dilated_fourier_hybrid_encoder'


def layer_norm(x, g=None, b=None):
    x32 = x.astype(jnp.float32)
    mu = jnp.mean(x32, axis=-1, keepdims=True)
    xc = x32 - mu
    var = jnp.mean(xc * xc, axis=-1, keepdims=True)
    y = xc * lax.rsqrt(var + LN_EPS)
    if g is not None:
        y = y * g.astype(jnp.float32) + b.astype(jnp.float32)
    return y.astype(x.dtype)


def rope(t, pos):
    half = HEAD_DIM // 2
    inv = ROPE_THETA ** (-jnp.arange(half, dtype=jnp.float32) / half)
    ang = pos.astype(jnp.float32)[:, None] * inv[None, :]
    cos = jnp.cos(ang)[None, :, None, :]
    sin = jnp.sin(ang)[None, :, None, :]
    t32 = t.astype(jnp.float32)
    t1, t2 = t32[..., :half], t32[..., half:]
    return jnp.concatenate([t1 * cos - t2 * sin, t2 * cos + t1 * sin], axis=-1).astype(t.dtype)


def banded_attention(q, k, v, radius):
    n, L, h, dh = q.shape
    blk = radius
    nb = -(-L // blk)
    lp = nb * blk
    qb = jnp.pad(q, ((0, 0), (0, lp - L), (0, 0), (0, 0))).reshape(n, nb, blk, h, dh)

    def kv_blocks(t):
        tp = jnp.pad(t, ((0, 0), (blk, lp - L + blk), (0, 0), (0, 0))).reshape(n, nb + 2, blk, h, dh)
        return jnp.concatenate([tp[:, :-2], tp[:, 1:-1], tp[:, 2:]], axis=2)

    kb = kv_blocks(k)
    vb = kv_blocks(v)
    s = jnp.einsum('nbqhd,nbkhd->nbhqk', qb, kb, preferred_element_type=jnp.float32) * (dh ** -0.5)
    qi = jnp.arange(blk)[:, None]
    kj = jnp.arange(3 * blk)[None, :]
    rel = kj - qi
    band = (rel >= 0) & (rel <= 2 * blk)
    kpos = (jnp.arange(nb)[:, None] - 1) * blk + jnp.arange(3 * blk)[None, :]
    valid = (kpos >= 0) & (kpos < L)
    mask = band[None, :, :] & valid[:, None, :]
    s = jnp.where(mask[None, :, None, :, :], s, NEG_INF)
    m = jnp.max(s, axis=-1, keepdims=True)
    p = jnp.exp(s - m)
    den = jnp.sum(p, axis=-1, keepdims=True)
    o = jnp.einsum('nbhqk,nbkhd->nbqhd', p, vb.astype(jnp.float32))
    o = o / jnp.swapaxes(den, 2, 3)
    lse = jnp.swapaxes((m + jnp.log(den))[..., 0], 2, 3)
    o = o.reshape(n, lp, h, dh)[:, :L]
    lse = lse.reshape(n, lp, h)[:, :L]
    return o, lse


def dilated_attention(q, k, v, dilation, radius):
    b, s, h, dh = q.shape
    L = s // dilation

    def split(t):
        return t.reshape(b, L, dilation, h, dh).transpose(0, 2, 1, 3, 4).reshape(b * dilation, L, h, dh)

    o, lse = banded_attention(split(q), split(k), split(v), radius)
    o = o.reshape(b, dilation, L, h, dh).transpose(0, 2, 1, 3, 4).reshape(b, s, h, dh)
    lse = lse.reshape(b, dilation, L, h).transpose(0, 2, 1, 3).reshape(b, s, h)
    return o, lse


def fourier_mix(f):
    b, s, _ = f.shape
    fg = f.astype(jnp.float32).reshape(b, s, FOURIER_GROUPS, FOURIER_GROUP_DIM)
    out = jnp.fft.fft2(fg, axes=(1, 3), norm='ortho').real
    return out.reshape(b, s, FOURIER_WIDTH).astype(f.dtype)


def encoder_layer(x, c, w_ada, b_ada, w_in, w_attn_up, w_fourier_up, w_mix_out,
                  ln1_g, ln1_b, w_gate, w_up, w_down, ln2_g, ln2_b):
    b, s, d = x.shape
    mod = jnp.dot(jax.nn.silu(c), w_ada) + b_ada
    shift_m, scale_m, gate_m, shift_f, scale_f, gate_f = [t[:, None, :] for t in jnp.split(mod, N_MOD, axis=-1)]

    h = layer_norm(x) * (1 + scale_m) + shift_m
    proj = jnp.dot(h, w_in)
    q, k, v, f, g_attn, g_four = jnp.split(proj, SPLIT_POINTS, axis=-1)
    pos = jnp.arange(s)
    q = rope(q.reshape(b, s, N_ATTN_HEADS, HEAD_DIM), pos)
    k = rope(k.reshape(b, s, N_ATTN_HEADS, HEAD_DIM), pos)
    v = v.reshape(b, s, N_ATTN_HEADS, HEAD_DIM)
    outs, lses = [], []
    for gi, (win, dil) in enumerate(DILATED_GROUPS):
        sl = slice(gi * HEADS_PER_GROUP, (gi + 1) * HEADS_PER_GROUP)
        o, l = dilated_attention(q[:, :, sl], k[:, :, sl], v[:, :, sl], dil, win // (2 * dil))
        outs.append(o)
        lses.append(l)
    wts = jax.nn.softmax(jnp.stack(lses), axis=0)
    attn = jnp.einsum('gbsh,gbshd->bshd', wts, jnp.stack(outs)).astype(x.dtype)
    a_branch = jnp.dot(attn.reshape(b, s, ATTN_OUT_WIDTH), w_attn_up)
    f_branch = jnp.dot(fourier_mix(f), w_fourier_up)
    merged = jax.nn.sigmoid(g_attn) * a_branch + jax.nn.sigmoid(g_four) * f_branch
    mix = jnp.dot(merged, w_mix_out)
    x = layer_norm(DEEPNORM_ALPHA * x + gate_m * mix, ln1_g, ln1_b)

    h2 = layer_norm(x) * (1 + scale_f) + shift_f
    ffn = jnp.dot(jax.nn.silu(jnp.dot(h2, w_gate)) * jnp.dot(h2, w_up), w_down)
    x = layer_norm(DEEPNORM_ALPHA * x + gate_f * ffn, ln2_g, ln2_b)
    return x


def trunk(x, c, w_ada, b_ada, w_in, w_attn_up, w_fourier_up, w_mix_out,
          ln1_g, ln1_b, w_gate, w_up, w_down, ln2_g, ln2_b):
    for l in range(DEPTH):
        x = encoder_layer(x, c, w_ada[l], b_ada[l], w_in[l], w_attn_up[l], w_fourier_up[l], w_mix_out[l],
                          ln1_g[l], ln1_b[l], w_gate[l], w_up[l], w_down[l], ln2_g[l], ln2_b[l])
    return x


def setup_inputs(seed: int = 0) -> dict:
    key = jax.random.key(seed)
    ks = jax.random.split(key, 20)
    f32 = jnp.float32
    nrm = lambda k, shape, scale: jax.random.normal(k, shape, f32) * scale
    beta = DEEPNORM_BETA
    col_scale = jnp.ones((IN_WIDTH,), f32).at[2 * ATTN_WIDTH:3 * ATTN_WIDTH].set(beta)
    return {
        'x_prompt': nrm(ks[0], (BATCH, SEQ, D_MODEL), 1.0),
        'x_sample': nrm(ks[1], (DEC_BATCH, DEC_SEQ, D_MODEL), 1.0),
        'c_prompt': nrm(ks[2], (BATCH, D_MODEL), 1.0),
        'c_sample': nrm(ks[3], (DEC_BATCH, D_MODEL), 1.0),
        'w_ada': nrm(ks[4], (DEPTH, D_MODEL, N_MOD * D_MODEL), 0.5 * D_MODEL ** -0.5),
        'b_ada': nrm(ks[5], (DEPTH, N_MOD * D_MODEL), 0.02),
        'w_in': nrm(ks[6], (DEPTH, D_MODEL, IN_WIDTH), D_MODEL ** -0.5) * col_scale,
        'w_attn_up': nrm(ks[7], (DEPTH, ATTN_OUT_WIDTH, D_MODEL), beta * ATTN_OUT_WIDTH ** -0.5),
        'w_fourier_up': nrm(ks[8], (DEPTH, FOURIER_WIDTH, D_MODEL), beta * FOURIER_WIDTH ** -0.5),
        'w_mix_out': nrm(ks[9], (DEPTH, D_MODEL, D_MODEL), beta * D_MODEL ** -0.5),
        'ln1_g': 1.0 + nrm(ks[10], (DEPTH, D_MODEL), 0.02),
        'ln1_b': nrm(ks[11], (DEPTH, D_MODEL), 0.02),
        'w_gate': nrm(ks[12], (DEPTH, D_MODEL, D_FF), beta * D_MODEL ** -0.5),
        'w_up': nrm(ks[13], (DEPTH, D_MODEL, D_FF), beta * D_MODEL ** -0.5),
        'w_down': nrm(ks[14], (DEPTH, D_FF, D_MODEL), beta * D_FF ** -0.5),
        'ln2_g': 1.0 + nrm(ks[15], (DEPTH, D_MODEL), 0.02),
        'ln2_b': nrm(ks[16], (DEPTH, D_MODEL), 0.02),
    }


def reference(x_prompt, x_sample, c_prompt, c_sample, w_ada, b_ada, w_in, w_attn_up, w_fourier_up,
              w_mix_out, ln1_g, ln1_b, w_gate, w_up, w_down, ln2_g, ln2_b):
    y_prompt = trunk(x_prompt, c_prompt, w_ada, b_ada, w_in, w_attn_up, w_fourier_up, w_mix_out,
                     ln1_g, ln1_b, w_gate, w_up, w_down, ln2_g, ln2_b)
    y_sample = trunk(x_sample, c_sample, w_ada, b_ada, w_in, w_attn_up, w_fourier_up, w_mix_out,
                     ln1_g, ln1_b, w_gate, w_up, w_down, ln2_g, ln2_b)
    return (y_prompt, y_sample)
```

```cpp
#include <hip/hip_runtime.h>
#include <cstdio>
#include <cstdint>
namespace pg8 {
#define PG8_LAS __attribute__((address_space(3)))
typedef unsigned short bf16_t;
typedef short bf16x8 __attribute__((ext_vector_type(8)));
typedef float f32x4 __attribute__((ext_vector_type(4)));
typedef unsigned u32x4 __attribute__((ext_vector_type(4)));
typedef int v4i_t __attribute__((ext_vector_type(4)));
typedef int v8i_t __attribute__((ext_vector_type(8)));
constexpr int BM = 256, BK = 64, HALF = 128, HTB = HALF * BK * 2  , STAGE_BYTES = 8 * HTB, NXCD = 8, WGM = 8;

__host__ __device__ __forceinline__ int lds_byte(int r, int c) { const int st = (r >> 4) * 2 + (c >> 5), rr = r & 15, cc = c & 31, ob = rr * 64 + cc * 2; return st * 1024 + (ob ^ (((ob >> 9) & 1) << 5)); }
__host__ __device__ __forceinline__ void stage_rc(int b, int& R, int& C) { const int st = b / 1024, sb = b % 1024, swz = sb ^ (((sb >> 9) & 1) << 5); R = (st >> 1) * 16 + swz / 64; C = (st & 1) * 32 + (swz % 64) / 2; }
__host__ __device__ __forceinline__ int perm32(int rho) { const int n = rho >> 4, i = rho & 15; return 8 * (i >> 2) + 4 * n + (i & 3); }

struct Unit { int pm, pn; };
struct Gemm { const bf16_t* A; const bf16_t* Bt; int M, N, K; int sw = 0x79797979, sa = 0x7f7f7f7f; };

struct StaticOrder {
    int nM, nN, nwg, G, c;
    __host__ __device__ void init(int M, int N, int G_, int c_) { nM = M / BM; nN = N / BM; nwg = nM * nN; G = G_; c = c_; }
    __host__ __device__ bool next(int i, Unit& u) const {
        const long L = (long)i * G + c; if (L >= nwg) return false;
        int wgid = (int)L; { const int q = nwg / NXCD, r = nwg % NXCD, xcd = wgid % NXCD, off = wgid / NXCD; wgid = (xcd < r ? xcd * (q + 1) : r * (q + 1) + (xcd - r) * q) + off; }
        const int nig = WGM * nN, gid = wgid / nig, fm = gid * WGM, gsz = (nM - fm) < WGM ? (nM - fm) : WGM;
        u.pm = fm + ((wgid % nig) % gsz); u.pn = (wgid % nig) / gsz; return true;
    }
    __device__ __forceinline__ void a_ready(const Unit&) const {}
    __device__ __forceinline__ void done(const Unit&) const {}
    static constexpr bool BGATHER = false;
    __device__ __forceinline__ size_t b_off(int) const { return 0; }
    int brow_bytes = 0;
};
struct DftOrder : StaticOrder {
    static constexpr bool BGATHER = true;
    int tsh; size_t gjump;
    __device__ __forceinline__ size_t b_off(int pn) const { return (size_t)pn * 1024 + (size_t)(pn >> tsh) * gjump; }
};

typedef float cvt_f32x2 __attribute__((ext_vector_type(2))); typedef __bf16 cvt_bf16x2 __attribute__((ext_vector_type(2)));
__device__ __forceinline__ unsigned cvt_pk_bf16(float lo, float hi) { cvt_f32x2 v = {lo, hi}; cvt_bf16x2 b = __builtin_convertvector(v, cvt_bf16x2); return __builtin_bit_cast(unsigned, b); }
typedef unsigned u32x2 __attribute__((ext_vector_type(2)));
typedef float f32x2 __attribute__((ext_vector_type(2)));
__device__ __forceinline__ float bf_lo(unsigned w) { return __uint_as_float(w << 16); }
__device__ __forceinline__ float bf_hi(unsigned w) { return __uint_as_float(w & 0xffff0000u); }
__device__ __forceinline__ float sigm(float x) { return __builtin_amdgcn_rcpf(1.0f + __expf(-x)); }

struct EpiBf16S {
    static constexpr bool PERM = true, AFTER_DRAIN = false;
    bf16_t* O; int ldc; float scale;
    __device__ __forceinline__ void operator()(const f32x4 (&acc)[2][2][4][2], const Unit& u, int wr, int wc, int fr, int fq) const {
        const int row0 = u.pm * BM + wr * 64 + fr, col0 = u.pn * BM + wc * 32 + 8 * fq;
#pragma unroll
        for (int ai = 0; ai < 2; ++ai)
#pragma unroll
            for (int m = 0; m < 4; ++m) { bf16_t* rowp = O + (size_t)(row0 + ai * HALF + m * 16) * ldc + col0;
#pragma unroll
                for (int bj = 0; bj < 2; ++bj) { const f32x4 v0 = acc[ai][bj][m][0] * scale, v1 = acc[ai][bj][m][1] * scale;
                    u32x4 w; w.x = cvt_pk_bf16(v0[0], v0[1]); w.y = cvt_pk_bf16(v0[2], v0[3]); w.z = cvt_pk_bf16(v1[0], v1[1]); w.w = cvt_pk_bf16(v1[2], v1[3]);
                    *(u32x4*)(rowp + bj * HALF) = w; } }
    }
};
struct EpiFour {
    static constexpr bool PERM = true, AFTER_DRAIN = false;
    bf16_t* FO; int seq_off, nkb; float scale;
    __device__ __forceinline__ void operator()(const f32x4 (&acc)[2][2][4][2], const Unit& u, int wr, int wc, int fr, int fq) const {
        const int row0 = u.pm * BM + wr * 64 + fr, kb0 = wc * 32 + 8 * fq;
        if (kb0 >= nkb) return;
#pragma unroll
        for (int ai = 0; ai < 2; ++ai)
#pragma unroll
            for (int m = 0; m < 4; ++m) { const int row = row0 + ai * HALF + m * 16, cp = row & 255, gk = row >> 8, ka = gk & 127, g = gk >> 7;
                bf16_t* p = FO + (size_t)(seq_off + ka + 128 * kb0) * 1024 + g * 256 + cp;
#pragma unroll
                for (int n = 0; n < 2; ++n)
#pragma unroll
                    for (int j = 0; j < 4; ++j) { const unsigned w = cvt_pk_bf16(acc[ai][0][m][n][j] * scale, 0.f); p[(size_t)(128 * (4 * n + j)) * 1024] = (bf16_t)(w & 0xffffu); } }
    }
};
struct EpiTwT {
    static constexpr bool PERM = true, AFTER_DRAIN = false;
    bf16_t* A2; float scale; const float* tw;
    __device__ __forceinline__ void operator()(const f32x4 (&acc)[2][2][4][2], const Unit& u, int wr, int wc, int fr, int fq) const {
        const bool smp = u.pn >= 512; const int nsh = smp ? 6 : 7, tsh = smp ? 1 : 0  , Sm1 = smp ? 8191 : 16383; const int roff = smp ? 131072 : 0;
#pragma unroll
        for (int m = 0; m < 4; ++m) { const int ka = wr * 64 + m * 16 + fr;
            const f32x2 st_ = *(const f32x2*)(tw + 2 * (ka << tsh)); const float scs = st_[0], ssn = st_[1];
#pragma unroll
            for (int bj = 0; bj < 2; ++bj) { const int rho = u.pn * BM + bj * HALF + wc * 32 + 8 * fq - roff, slo = rho & ((1 << nsh) - 1), cg = rho >> nsh, g = cg & 3, cp = cg >> 2;
                const f32x2 t0_ = *(const f32x2*)(tw + 2 * (((ka * slo) & Sm1) << tsh));
                bf16_t* p = A2 + ((size_t)roff + (size_t)((g * 128 + ka) * 256 + cp)) * 256 + slo;
#pragma unroll
                for (int ri = 0; ri < 2; ++ri) { float cs = t0_[0], sn = t0_[1]; float o_[8];
#pragma unroll
                    for (int n = 0; n < 2; ++n)
#pragma unroll
                        for (int j = 0; j < 4; ++j) { const float yr = acc[0][bj][m][n][j] * scale, yi = acc[1][bj][m][n][j] * scale; o_[4 * n + j] = ri ? yi * cs - yr * sn : yr * cs + yi * sn;
                            const float c2 = cs * scs - sn * ssn; sn = sn * scs + cs * ssn; cs = c2; }
                    u32x4 w; w.x = cvt_pk_bf16(o_[0], o_[1]); w.y = cvt_pk_bf16(o_[2], o_[3]); w.z = cvt_pk_bf16(o_[4], o_[5]); w.w = cvt_pk_bf16(o_[6], o_[7]); *(u32x4*)(p + 128 * ri) = w; }
                if (smp) { const u32x4 z = {0u, 0u, 0u, 0u}; *(u32x4*)(p + 64) = z; *(u32x4*)(p + 192) = z; } }
            asm volatile("" ::: "memory"); }
    }
};
struct EpiA1 {
    static constexpr bool PERM = true, AFTER_DRAIN = false;
    bf16_t* A1; int tsh, nsh; float scale;
    __device__ __forceinline__ void operator()(const f32x4 (&acc)[2][2][4][2], const Unit& u, int wr, int wc, int fr, int fq) const {
        const int g = u.pn >> tsh, t = u.pn & ((1 << tsh) - 1), sh0 = wc * 32 + 8 * fq, ri = u.pm;
#pragma unroll
        for (int ai = 0; ai < 2; ++ai)
#pragma unroll
            for (int m = 0; m < 4; ++m) { const int cp = ai * HALF + wr * 64 + m * 16 + fr;
#pragma unroll
                for (int bj = 0; bj < 2; ++bj) { const int slo = 2 * t + bj; const f32x4 v0 = acc[ai][bj][m][0] * scale, v1 = acc[ai][bj][m][1] * scale;
                    u32x4 w; w.x = cvt_pk_bf16(v0[0], v0[1]); w.y = cvt_pk_bf16(v0[2], v0[3]); w.z = cvt_pk_bf16(v1[0], v1[1]); w.w = cvt_pk_bf16(v1[2], v1[3]);
                    *(u32x4*)(A1 + (size_t)((((cp * 4 + g) << nsh) + slo)) * 256 + ri * 128 + sh0) = w; } }
    }
};
__device__ __forceinline__ void pair_store_bf16(bf16_t* rowp_even  , size_t row_stride, const u32x4& x0, const u32x4& x1, bool odd) {
    u32x4 s_, r_, d1, d2;
#pragma unroll
    for (int k = 0; k < 4; ++k) { s_[k] = odd ? x0[k] : x1[k]; r_[k] = (unsigned)__builtin_amdgcn_mov_dpp((int)s_[k], 0xB1, 0xF, 0xF, true); d1[k] = odd ? r_[k] : x0[k]; d2[k] = odd ? x1[k] : r_[k]; }
    *(u32x4*)rowp_even = d1; *(u32x4*)(rowp_even + row_stride) = d2;
}
struct EpiQKVF {
    static constexpr bool PERM = true, AFTER_DRAIN = false;
    bf16_t *Q, *Kb, *V, *F; const float* rope; int pn_off;
    __device__ __forceinline__ void operator()(const f32x4 (&acc)[2][2][4][2], const Unit& u, int wr, int wc, int fr, int fq) const {
        const int row0 = u.pm * BM + wr * 64 + fr; const int pn = u.pn + pn_off;
        if (pn < 24) {
            bf16_t* base = pn < 12 ? Q : Kb; const int hp = pn < 12 ? pn : pn - 12;
            const int seq_off = u.pm >= 64 ? 16384 : 0;
            const float qs = pn < 12 ? 0.08838834764831845f * 1.4426950408889634f : 1.0f;
            const int head = 2 * hp + (wc >> 1), d0 = 32 * (wc & 1) + 8 * fq;
#pragma unroll
            for (int ai = 0; ai < 2; ++ai)
#pragma unroll
                for (int m = 0; m < 4; ++m) { const int row = row0 + ai * HALF + m * 16; const int pos = row - seq_off;
                    const u32x4* rp = (const u32x4*)((const unsigned*)rope + ((size_t)pos * 64 + d0));
                    u32x4 wa, wb;
#pragma unroll
                    for (int bj = 0; bj < 2; ++bj) { const u32x4 rr = rp[bj];
                        const float cs[4] = {bf_lo(rr[0]), bf_lo(rr[1]), bf_lo(rr[2]), bf_lo(rr[3])}, sn[4] = {bf_hi(rr[0]), bf_hi(rr[1]), bf_hi(rr[2]), bf_hi(rr[3])};
                        const f32x4 t1 = acc[ai][bj][m][0], t2 = acc[ai][bj][m][1]; float o1[4], o2[4];
#pragma unroll
                        for (int j = 0; j < 4; ++j) { o1[j] = (t1[j] * cs[j] - t2[j] * sn[j]) * qs; o2[j] = (t2[j] * cs[j] + t1[j] * sn[j]) * qs; }
                        wa[2 * bj] = cvt_pk_bf16(o1[0], o1[1]); wa[2 * bj + 1] = cvt_pk_bf16(o1[2], o1[3]); wb[2 * bj] = cvt_pk_bf16(o2[0], o2[1]); wb[2 * bj + 1] = cvt_pk_bf16(o2[2], o2[3]); }
                    const bool odd = fr & 1;
                    pair_store_bf16(base + (size_t)(row - (odd ? 1 : 0)) * 3072 + head * 128 + 64 * (wc & 1) + 8 * fq + (odd ? 32 : 0), 3072, wa, wb, odd); }
        } else {
            if (pn < 36) {
                unsigned char* vb = (unsigned char*)V + (size_t)((pn - 24) * 256 + wc * 64 + 16 * fq);
#pragma unroll
                for (int ai = 0; ai < 2; ++ai)
#pragma unroll
                    for (int m = 0; m < 4; ++m) { unsigned char* rowp = vb + (size_t)(row0 + ai * HALF + m * 16) * 3072; u32x4 w;
#pragma unroll
                        for (int bj = 0; bj < 2; ++bj) { const f32x4 v0 = acc[ai][bj][m][0] * 16.f, v1 = acc[ai][bj][m][1] * 16.f; int t = 0;
                            t = __builtin_amdgcn_cvt_pk_fp8_f32(v0[0], v0[1], t, false); t = __builtin_amdgcn_cvt_pk_fp8_f32(v0[2], v0[3], t, true); w[2 * bj] = (unsigned)t; t = 0;
                            t = __builtin_amdgcn_cvt_pk_fp8_f32(v1[0], v1[1], t, false); t = __builtin_amdgcn_cvt_pk_fp8_f32(v1[2], v1[3], t, true); w[2 * bj + 1] = (unsigned)t; }
                        *(u32x4*)rowp = w; }
                return; }
            bf16_t* base = F + (size_t)(pn - 36) * 24576 * 256; const bool odd = fr & 1;
#pragma unroll
            for (int ai = 0; ai < 2; ++ai)
#pragma unroll
                for (int m = 0; m < 4; ++m) { u32x4 w[2];
#pragma unroll
                    for (int bj = 0; bj < 2; ++bj) { const f32x4 v0 = acc[ai][bj][m][0], v1 = acc[ai][bj][m][1];
                        w[bj].x = cvt_pk_bf16(v0[0], v0[1]); w[bj].y = cvt_pk_bf16(v0[2], v0[3]); w[bj].z = cvt_pk_bf16(v1[0], v1[1]); w[bj].w = cvt_pk_bf16(v1[2], v1[3]); }
                    pair_store_bf16(base + (size_t)(row0 + ai * HALF + m * 16 - (odd ? 1 : 0)) * 256 + wc * 64 + 16 * fq + (odd ? 8 : 0), 256, w[0], w[1], odd); }
        }
    }
};
__device__ __forceinline__ size_t pr_off(size_t row, int col, int width) { return (row >> 1) * (size_t)(2 * width) + (size_t)((col & ~63) << 1) + ((row & 1) << 6) + (col & 63); }
struct EpiGates {
    static constexpr bool PERM = true, AFTER_DRAIN = false;
    unsigned char* G;
    static __device__ __forceinline__ unsigned q8x4(const f32x4 v) {
        const f32x4 e = {__builtin_amdgcn_exp2f(-v[0]), __builtin_amdgcn_exp2f(-v[1]), __builtin_amdgcn_exp2f(-v[2]), __builtin_amdgcn_exp2f(-v[3])}; const f32x4 den = e + 1.0f;
        const f32x4 r = {__builtin_amdgcn_rcpf(den[0]), __builtin_amdgcn_rcpf(den[1]), __builtin_amdgcn_rcpf(den[2]), __builtin_amdgcn_rcpf(den[3])}; const f32x4 q = r * 256.f + 0.5f;
        return (unsigned)fminf(q[0], 255.5f) | ((unsigned)fminf(q[1], 255.5f) << 8) | ((unsigned)fminf(q[2], 255.5f) << 16) | ((unsigned)fminf(q[3], 255.5f) << 24); }
    __device__ __forceinline__ void operator()(const f32x4 (&acc)[2][2][4][2], const Unit& u, int wr, int wc, int fr, int fq) const {
        const int row0 = u.pm * BM + wr * 64 + fr, col0 = u.pn * BM + wc * 64 + 16 * fq;
#pragma unroll
        for (int ai = 0; ai < 2; ++ai)
#pragma unroll
            for (int m = 0; m < 4; ++m) { unsigned char* rowp = G + pr_off((size_t)(row0 + ai * HALF + m * 16), col0, 8192); u32x4 w;
#pragma unroll
                for (int bj = 0; bj < 2; ++bj) { const f32x4 v0 = acc[ai][bj][m][0], v1 = acc[ai][bj][m][1];
                    w[2 * bj] = q8x4(v0); w[2 * bj + 1] = q8x4(v1); }
                *(u32x4*)rowp = w; }
    }
};
template <int MODE> struct EpiBranch {
    static constexpr bool PERM = true, AFTER_DRAIN = false;
    const unsigned char* G; bf16_t* Mg; unsigned char* Ma;
    static __device__ __forceinline__ float ub(unsigned w, int k) { return (float)((w >> (8 * k)) & 255u); }
    __device__ __forceinline__ void operator()(const f32x4 (&acc)[2][2][4][2], const Unit& u, int wr, int wc, int fr, int fq) const {
        const int row0 = u.pm * BM + wr * 64 + fr;
        if constexpr (MODE == 0) {
            const int col0 = u.pn * BM + wc * 64 + 16 * fq;
#pragma unroll
            for (int ai = 0; ai < 2; ++ai)
#pragma unroll
                for (int m = 0; m < 4; ++m) { const size_t row = (size_t)(row0 + ai * HALF + m * 16);
                    const u32x4 g = *(const u32x4*)(G + pr_off(row, col0, 8192)); u32x4 w;
#pragma unroll
                    for (int bj = 0; bj < 2; ++bj) { const f32x4 v0 = acc[ai][bj][m][0], v1 = acc[ai][bj][m][1]; const unsigned g0 = g[2 * bj], g1 = g[2 * bj + 1]; int t = 0;
                        t = __builtin_amdgcn_cvt_pk_fp8_f32(64.f * ub(g0, 0) * v0[0], 64.f * ub(g0, 1) * v0[1], t, false); t = __builtin_amdgcn_cvt_pk_fp8_f32(64.f * ub(g0, 2) * v0[2], 64.f * ub(g0, 3) * v0[3], t, true); w[2 * bj] = (unsigned)t; t = 0;
                        t = __builtin_amdgcn_cvt_pk_fp8_f32(64.f * ub(g1, 0) * v1[0], 64.f * ub(g1, 1) * v1[1], t, false); t = __builtin_amdgcn_cvt_pk_fp8_f32(64.f * ub(g1, 2) * v1[2], 64.f * ub(g1, 3) * v1[3], t, true); w[2 * bj + 1] = (unsigned)t; }
                    *(u32x4*)(Ma + pr_off(row, col0, 4096)) = w; }
        } else {
            const int col0 = u.pn * BM + wc * 64 + 16 * fq; const bool odd = fr & 1;
#pragma unroll
            for (int ai = 0; ai < 2; ++ai)
#pragma unroll
                for (int m = 0; m < 4; ++m) { const size_t row = (size_t)(row0 + ai * HALF + m * 16);
                    const u32x4 g4 = *(const u32x4*)(G + pr_off(row, 4096 + col0, 8192)), p4 = *(const u32x4*)(Ma + pr_off(row, col0, 4096)); u32x4 w[2];
#pragma unroll
                    for (int bj = 0; bj < 2; ++bj) { const f32x4 v0 = acc[ai][bj][m][0], v1 = acc[ai][bj][m][1];
                        const unsigned gx = g4[2 * bj], gy = g4[2 * bj + 1], px = p4[2 * bj], py = p4[2 * bj + 1];
                        float o[8] = {ub(gx, 0) * v0[0], ub(gx, 1) * v0[1], ub(gx, 2) * v0[2], ub(gx, 3) * v0[3], ub(gy, 0) * v1[0], ub(gy, 1) * v1[1], ub(gy, 2) * v1[2], ub(gy, 3) * v1[3]};
                        const cvt_f32x2 p0 = __builtin_amdgcn_cvt_pk_f32_fp8((int)px, false), p1 = __builtin_amdgcn_cvt_pk_f32_fp8((int)px, true), p2 = __builtin_amdgcn_cvt_pk_f32_fp8((int)py, false), p3 = __builtin_amdgcn_cvt_pk_f32_fp8((int)py, true);
                        o[0] += 0.015625f * p0[0]; o[1] += 0.015625f * p0[1]; o[2] += 0.015625f * p1[0]; o[3] += 0.015625f * p1[1]; o[4] += 0.015625f * p2[0]; o[5] += 0.015625f * p2[1]; o[6] += 0.015625f * p3[0]; o[7] += 0.015625f * p3[1];
                        w[bj].x = cvt_pk_bf16(o[0], o[1]); w[bj].y = cvt_pk_bf16(o[2], o[3]); w[bj].z = cvt_pk_bf16(o[4], o[5]); w[bj].w = cvt_pk_bf16(o[6], o[7]); }
                    pair_store_bf16(Mg + (row - (odd ? 1 : 0)) * 4096 + col0 + (odd ? 8 : 0), 4096, w[0], w[1], odd); }
        }
    }
};
struct EpiResid {
    static constexpr bool PERM = false, AFTER_DRAIN = false;
    const float* base0; const float* base1; float* out; const float* gate0; const float* gate1; float alpha;
    __device__ __forceinline__ void operator()(const f32x4 (&acc)[2][2][4][2], const Unit& u, int wr, int wc, int fr, int fq) const {
        const int row0 = u.pm * BM + wr * 64 + fr, col0 = u.pn * BM + wc * 32 + 4 * fq;
        const bool smp = u.pm >= 64; const float* gate = smp ? gate1 : gate0; const float* bs = smp ? base1 - (size_t)16384 * 4096 : base0;
        f32x4 gv[2][2];
#pragma unroll
        for (int bj = 0; bj < 2; ++bj)
#pragma unroll
            for (int n = 0; n < 2; ++n) gv[bj][n] = *(const f32x4*)(gate + col0 + bj * HALF + n * 16);
#pragma unroll
        for (int ai = 0; ai < 2; ++ai)
#pragma unroll
            for (int m = 0; m < 4; ++m) { const size_t off = (size_t)(row0 + ai * HALF + m * 16) * 4096 + col0;
#pragma unroll
                for (int bj = 0; bj < 2; ++bj)
#pragma unroll
                    for (int n = 0; n < 2; ++n) { const f32x4 b = *(const f32x4*)(bs + off + bj * HALF + n * 16);
                        *(f32x4*)(out + off + bj * HALF + n * 16) = b * alpha + gv[bj][n] * acc[ai][bj][m][n]; } }
    }
};
struct EpiContrib {
    static constexpr bool PERM = true, AFTER_DRAIN = false;
    bf16_t* C; const float* gate0; const float* gate1;
    __device__ __forceinline__ void operator()(const f32x4 (&acc)[2][2][4][2], const Unit& u, int wr, int wc, int fr, int fq) const {
        const int row0 = u.pm * BM + wr * 64 + fr, col0 = u.pn * BM + wc * 64 + 16 * fq;
        const float* gate = u.pm >= 64 ? gate1 : gate0; const bool odd = fr & 1;
        f32x4 gv[2][2];
#pragma unroll
        for (int bj = 0; bj < 2; ++bj)
#pragma unroll
            for (int n = 0; n < 2; ++n) gv[bj][n] = *(const f32x4*)(gate + col0 + bj * 8 + 4 * n);
#pragma unroll
        for (int ai = 0; ai < 2; ++ai)
#pragma unroll
            for (int m = 0; m < 4; ++m) { u32x4 w[2];
#pragma unroll
                for (int bj = 0; bj < 2; ++bj) { const f32x4 v0 = acc[ai][bj][m][0] * gv[bj][0], v1 = acc[ai][bj][m][1] * gv[bj][1];
                    w[bj].x = cvt_pk_bf16(v0[0], v0[1]); w[bj].y = cvt_pk_bf16(v0[2], v0[3]); w[bj].z = cvt_pk_bf16(v1[0], v1[1]); w[bj].w = cvt_pk_bf16(v1[2], v1[3]); }
                pair_store_bf16(C + (size_t)(row0 + ai * HALF + m * 16 - (odd ? 1 : 0)) * 4096 + col0 + (odd ? 8 : 0), 4096, w[0], w[1], odd); }
    }
};
constexpr float LOG2E_16 = 1.4426950408889634f / 16.0f;
struct EpiGU {
    static constexpr bool PERM = true, AFTER_DRAIN = false;
    unsigned char* Hd;
    __device__ __forceinline__ void operator()(const f32x4 (&acc)[2][2][4][2], const Unit& u, int wr, int wc, int fr, int fq) const {
        const int row0 = u.pm * BM + wr * 64 + fr, col0 = u.pn * 128 + wc * 32 + 8 * fq;
#pragma unroll
        for (int ai = 0; ai < 2; ++ai)
#pragma unroll
            for (int m = 0; m < 4; ++m) { unsigned char* rowp = Hd + (size_t)(row0 + ai * HALF + m * 16) * 11008 + col0; u32x2 w2;
#pragma unroll
                for (int bj = 0; bj < 2; ++bj) { const f32x4 g = acc[ai][bj][m][0], up = acc[ai][bj][m][1];
                    const f32x4 e = {__builtin_amdgcn_exp2f(-g[0]), __builtin_amdgcn_exp2f(-g[1]), __builtin_amdgcn_exp2f(-g[2]), __builtin_amdgcn_exp2f(-g[3])};
                    const f32x4 den = e * LOG2E_16 + LOG2E_16;
                    const f32x4 rc = {__builtin_amdgcn_rcpf(den[0]), __builtin_amdgcn_rcpf(den[1]), __builtin_amdgcn_rcpf(den[2]), __builtin_amdgcn_rcpf(den[3])};
                    const f32x4 o = (g * up) * rc;
                    int w = 0; w = __builtin_amdgcn_cvt_pk_fp8_f32(o[0], o[1], w, false); w = __builtin_amdgcn_cvt_pk_fp8_f32(o[2], o[3], w, true);
                    w2[bj] = (unsigned)w; }
                *(u32x2*)rowp = w2; }
    }
};
template <class Epi, class Sched, bool ALIGN_EPI = false, bool SP2 = false, bool FP8 = false>
__device__ __forceinline__ void gemm_phase(PG8_LAS unsigned char* lds, const Gemm g, const Sched& S, const Epi& E, int tid_in) {
    int tid_ = tid_in; asm volatile("" : "+v"(tid_));
    const int tid = tid_, wid = __builtin_amdgcn_readfirstlane(tid >> 6), lane = tid & 63, wr = wid >> 2, wc = wid & 3, fr = lane & 15, fq = lane >> 4;
    const int K = g.K, RB = FP8 ? K : 2 * K  , nt = RB / (BK * 2);
    unsigned voffA[2], voffB[2];
#pragma unroll
    for (int i = 0; i < 2; ++i) { int R, C; stage_rc(tid * 16 + i * 8192, R, C); const int Rb = Epi::PERM ? ((R & ~31) + perm32(R & 31)) : R;
        voffA[i] = (unsigned)(R * RB + C * 2); voffB[i] = (unsigned)(Rb * (Sched::BGATHER ? S.brow_bytes : RB) + C * 2); }
    const size_t kstep = (size_t)(BK * 2);
    const size_t hstep = (size_t)HALF * RB;
    const size_t tstep = 2 * hstep;
    const size_t hstepB = Sched::BGATHER ? (size_t)512 : hstep;
    const unsigned ldsw = (unsigned)wid * 1024u;
    const int aoff = lds_byte(wr * 64 + fr, fq * 8), boff = lds_byte(wc * 32 + fr, fq * 8);
#define PG8_SA(b, h) (((b) * 2 + (h)) * HTB)
#define PG8_SB(b, h) ((4 + (b) * 2 + (h)) * HTB)
#define PG8_STAGE(bufoff, gbase, voff) do { _Pragma("unroll") for (int _i = 0; _i < 2; ++_i) \
        __builtin_amdgcn_global_load_lds((const unsigned*)((const char*)(gbase) + (voff)[_i]), (PG8_LAS unsigned*)(lds + (bufoff) + ldsw + _i * 8192), 16, 0, 0); } while (0)
#define PG8_LDA(dst, b, h) do { if constexpr (FP8) { _Pragma("unroll") for (int m = 0; m < 4; ++m) { const v4i_t lo_ = *(const PG8_LAS v4i_t*)(lds + PG8_SA(b, h) + aoff + m * 2048), hi_ = *(const PG8_LAS v4i_t*)(lds + PG8_SA(b, h) + aoff + m * 2048 + 1024); dst##8[m] = __builtin_shufflevector(lo_, hi_, 0, 1, 2, 3, 4, 5, 6, 7); } } \
      else { _Pragma("unroll") for (int m = 0; m < 4; ++m) _Pragma("unroll") for (int k = 0; k < 2; ++k) dst[m][k] = *(const PG8_LAS bf16x8*)(lds + PG8_SA(b, h) + aoff + m * 2048 + k * 1024); } } while (0)
#define PG8_LDB(dst, b, h) do { if constexpr (FP8) { _Pragma("unroll") for (int n = 0; n < 2; ++n) { const v4i_t lo_ = *(const PG8_LAS v4i_t*)(lds + PG8_SB(b, h) + boff + n * 2048), hi_ = *(const PG8_LAS v4i_t*)(lds + PG8_SB(b, h) + boff + n * 2048 + 1024); dst##8[n] = __builtin_shufflevector(lo_, hi_, 0, 1, 2, 3, 4, 5, 6, 7); } } \
      else { _Pragma("unroll") for (int n = 0; n < 2; ++n) _Pragma("unroll") for (int k = 0; k < 2; ++k) dst[n][k] = *(const PG8_LAS bf16x8*)(lds + PG8_SB(b, h) + boff + n * 2048 + k * 1024); } } while (0)
#define PG8_MMA(ai, bj, At, Bt) do { __builtin_amdgcn_s_setprio(1); if constexpr (FP8) { _Pragma("unroll") for (int m = 0; m < 4; ++m) _Pragma("unroll") for (int n = 0; n < 2; ++n) \
        asm volatile("v_mfma_scale_f32_16x16x128_f8f6f4 %0, %1, %2, %0, %3, %4 op_sel_hi:[0,0,0]" : "+v"(acc[ai][bj][m][n]) : "v"(Bt##8[n]), "v"(At##8[m]), "v"(sc_w), "v"(sc_a)); } \
      else { _Pragma("unroll") for (int m = 0; m < 4; ++m) _Pragma("unroll") for (int n = 0; n < 2; ++n) _Pragma("unroll") for (int k = 0; k < 2; ++k) \
        acc[ai][bj][m][n] = __builtin_amdgcn_mfma_f32_16x16x32_bf16(Bt[n][k], At[m][k], acc[ai][bj][m][n], 0, 0, 0); } __builtin_amdgcn_s_setprio(0); } while (0)
#define PG8_WAIT_V(n) asm volatile("s_waitcnt vmcnt(" #n ")" ::: "memory")
#define PG8_WAIT_L(n) asm volatile("s_waitcnt lgkmcnt(" #n ")" ::: "memory")
#define PG8_BAR __builtin_amdgcn_s_barrier()
#define PG8_SCHED __builtin_amdgcn_sched_barrier(0)
    Unit cur, nxt; int ui = 0;
    if (!S.next(0, cur)) return;
    f32x4 acc[2][2][4][2];
#pragma unroll
    for (int a = 0; a < 2; ++a)
#pragma unroll
        for (int b = 0; b < 2; ++b)
#pragma unroll
            for (int m = 0; m < 4; ++m)
#pragma unroll
                for (int n = 0; n < 2; ++n) acc[a][b][m][n] = (f32x4){0.f, 0.f, 0.f, 0.f};
    int sc_w = g.sw, sc_a = g.sa; asm volatile("" : "+v"(sc_w), "+v"(sc_a));
    bf16x8 At[4][2], B0[2][2], B1[2][2]; v8i_t At8[4], B08[2], B18[2];
    const char* cA = (const char*)g.A + (size_t)cur.pm * tstep; const char* cB = (const char*)g.Bt + (Sched::BGATHER ? S.b_off(cur.pn) : (size_t)cur.pn * tstep);
    S.a_ready(cur);
    if constexpr (SP2) {
        PG8_STAGE(PG8_SB(0, 0), cB, voffB); PG8_STAGE(PG8_SB(0, 1), cB + hstepB, voffB); PG8_STAGE(PG8_SA(0, 0), cA, voffA); PG8_STAGE(PG8_SA(0, 1), cA + hstep, voffA);
        if (wr == 1) PG8_BAR;
        PG8_WAIT_V(2); PG8_BAR;
        PG8_STAGE(PG8_SB(1, 0), cB + kstep, voffB); PG8_STAGE(PG8_SA(1, 0), cA + kstep, voffA); PG8_STAGE(PG8_SB(1, 1), cB + hstepB + kstep, voffB);
        PG8_WAIT_V(6); PG8_BAR;
    } else {
        PG8_STAGE(PG8_SB(0, 0), cB, voffB); PG8_STAGE(PG8_SA(0, 0), cA, voffA); PG8_STAGE(PG8_SB(0, 1), cB + hstepB, voffB); PG8_STAGE(PG8_SA(0, 1), cA + hstep, voffA);
        if (wr == 1) PG8_BAR;
        PG8_WAIT_V(4); PG8_BAR;
        PG8_STAGE(PG8_SB(1, 0), cB + kstep, voffB); PG8_STAGE(PG8_SA(1, 0), cA + kstep, voffA); PG8_STAGE(PG8_SB(1, 1), cB + hstepB + kstep, voffB);
        PG8_WAIT_V(6); PG8_BAR;
    }
    for (;;) {
        const bool has_next = S.next(ui + 1, nxt);
        const char* nA = has_next ? (const char*)g.A + (size_t)nxt.pm * tstep : cA; const char* nB = has_next ? (const char*)g.Bt + (Sched::BGATHER ? S.b_off(nxt.pn) : (size_t)nxt.pn * tstep) : cB;
        for (int t = 0; t < nt; t += 2) {
            const bool last = (t == nt - 2);
            const char* a1 = cA + (size_t)(t + 1) * kstep;
            const char* a2 = last ? nA : cA + (size_t)(t + 2) * kstep; const char* b2 = last ? nB : cB + (size_t)(t + 2) * kstep;
            const char* a3 = a2 + kstep; const char* b3 = b2 + kstep;
            if (last && has_next) S.a_ready(nxt);
            if constexpr (SP2) {
            PG8_LDB(B0, 0, 0); PG8_LDB(B1, 0, 1); PG8_SCHED; PG8_LDA(At, 0, 0); PG8_STAGE(PG8_SA(1, 1), a1 + hstep, voffA);
            PG8_WAIT_V(8); PG8_WAIT_L(0); PG8_BAR; PG8_MMA(0, 0, At, B0); PG8_MMA(0, 1, At, B1); PG8_BAR; PG8_SCHED;
            PG8_LDA(At, 0, 1); PG8_STAGE(PG8_SB(0, 0), b2, voffB); PG8_STAGE(PG8_SB(0, 1), b2 + hstepB, voffB); PG8_STAGE(PG8_SA(0, 0), a2, voffA);
            PG8_WAIT_V(8); PG8_WAIT_L(0); PG8_BAR; PG8_MMA(1, 0, At, B0); PG8_MMA(1, 1, At, B1); PG8_BAR; PG8_SCHED;
            PG8_LDB(B0, 1, 0); PG8_LDB(B1, 1, 1); PG8_SCHED; PG8_LDA(At, 1, 0); PG8_STAGE(PG8_SA(0, 1), a2 + hstep, voffA);
            PG8_WAIT_V(8); PG8_WAIT_L(0); PG8_BAR; PG8_MMA(0, 0, At, B0); PG8_MMA(0, 1, At, B1); PG8_BAR; PG8_SCHED;
            PG8_LDA(At, 1, 1); PG8_STAGE(PG8_SB(1, 0), b3, voffB); PG8_STAGE(PG8_SB(1, 1), b3 + hstepB, voffB); PG8_STAGE(PG8_SA(1, 0), a3, voffA);
            PG8_WAIT_V(8); PG8_WAIT_L(0); PG8_BAR; PG8_MMA(1, 0, At, B0); PG8_MMA(1, 1, At, B1); PG8_BAR; PG8_SCHED;
            } else {
            PG8_LDB(B0, 0, 0); PG8_SCHED; PG8_LDA(At, 0, 0); PG8_STAGE(PG8_SA(1, 1), a1 + hstep, voffA);
            PG8_WAIT_L(8); PG8_BAR; PG8_WAIT_L(0); PG8_MMA(0, 0, At, B0); PG8_BAR; PG8_SCHED;
            PG8_LDB(B1, 0, 1); PG8_STAGE(PG8_SB(0, 0), b2, voffB);
            PG8_BAR; PG8_WAIT_L(0); PG8_MMA(0, 1, At, B1); PG8_BAR;
            PG8_LDA(At, 0, 1); PG8_STAGE(PG8_SA(0, 0), a2, voffA);
            PG8_BAR; PG8_WAIT_L(0); PG8_MMA(1, 0, At, B0); PG8_BAR; PG8_SCHED;
            PG8_STAGE(PG8_SB(0, 1), b2 + hstepB, voffB);
            PG8_WAIT_V(6); PG8_BAR; PG8_MMA(1, 1, At, B1); PG8_BAR;
            PG8_LDB(B0, 1, 0); PG8_SCHED; PG8_LDA(At, 1, 0); PG8_STAGE(PG8_SA(0, 1), a2 + hstep, voffA);
            PG8_WAIT_L(8); PG8_BAR; PG8_WAIT_L(0); PG8_MMA(0, 0, At, B0); PG8_BAR; PG8_SCHED;
            PG8_LDB(B1, 1, 1); PG8_STAGE(PG8_SB(1, 0), b3, voffB);
            PG8_BAR; PG8_WAIT_L(0); PG8_MMA(0, 1, At, B1); PG8_BAR;
            PG8_LDA(At, 1, 1); PG8_STAGE(PG8_SA(1, 0), a3, voffA);
            PG8_BAR; PG8_WAIT_L(0); PG8_MMA(1, 0, At, B0); PG8_BAR; PG8_SCHED;
            PG8_STAGE(PG8_SB(1, 1), b3 + hstepB, voffB);
            PG8_WAIT_V(6); PG8_BAR; PG8_MMA(1, 1, At, B1); PG8_BAR;
            }
        }
        if constexpr (ALIGN_EPI) { if (wr == 0) PG8_BAR; }
        if constexpr (FP8) asm volatile("s_nop 15\n\ts_nop 15" ::: "memory");
        if constexpr (!Epi::AFTER_DRAIN) { E(acc, cur, wr, wc, fr, fq); S.done(cur); }
        if (!has_next) break;
#pragma unroll
        for (int a = 0; a < 2; ++a)
#pragma unroll
            for (int b = 0; b < 2; ++b)
#pragma unroll
                for (int m = 0; m < 4; ++m)
#pragma unroll
                    for (int n = 0; n < 2; ++n) acc[a][b][m][n] = (f32x4){0.f, 0.f, 0.f, 0.f};
        cur = nxt; cA = nA; cB = nB; ++ui;
        if constexpr (ALIGN_EPI) { if (wr == 1) PG8_BAR; }
    }
    PG8_WAIT_V(0);
    if constexpr (!ALIGN_EPI) { if (wr == 0) PG8_BAR; }
    PG8_BAR;
    if constexpr (Epi::AFTER_DRAIN) { E.fused(acc, cur, wr, wc, fr, fq, lds, wid, lane); S.done(cur); }
#undef PG8_SA
#undef PG8_SB
#undef PG8_STAGE
#undef PG8_LDA
#undef PG8_LDB
#undef PG8_MMA
#undef PG8_WAIT_V
#undef PG8_WAIT_L
#undef PG8_BAR
#undef PG8_SCHED
}
}

constexpr int S0 = 16384, S1 = 8192, M = S0 + S1, D = 4096, AW = 3072, NQKVF = 10240, NGATE = 8192, FF = 11008, NGU = 2 * FF, INW = 18432;
constexpr float LN_EPS = 1e-5f;
constexpr float ALPHA = 1.189207115002721f;
constexpr int NWAVES = 8;
#ifndef MK_ONE_LAUNCH
#define MK_ONE_LAUNCH 1
#endif
constexpr int NPHASES = 16;

constexpr size_t MiB = 1u << 20;
constexpr size_t WS_CTL = 0, CTL_ZERO_BYTES = 64 * 1024;
constexpr size_t WS_MODP = 1 * MiB;
constexpr size_t WS_MOD = 13 * MiB;
constexpr size_t WS_ROPE = 14 * MiB;
constexpr size_t WS_C256 = 22 * MiB;
constexpr size_t WS_D128 = WS_C256 + 256 * 1024;
constexpr size_t WS_D64 = WS_D128 + 128 * 1024;
constexpr size_t WS_TW = WS_D64 + 128 * 1024;
constexpr size_t WS_LSE = 24 * MiB;
constexpr size_t WS_W8 = 32 * MiB;
constexpr size_t WS_WF = 100 * MiB;
constexpr size_t WS_H8 = 1338 * MiB;
constexpr size_t WS_WAU = 176 * MiB;
constexpr size_t WS_WFU = 184 * MiB;
constexpr size_t WS_WMIX = 192 * MiB;
constexpr size_t WS_WGU = 224 * MiB;
constexpr size_t WS_WD = 396 * MiB;
constexpr size_t WS_H = 482 * MiB;
constexpr size_t WS_Q = 674 * MiB, WS_K = 818 * MiB, WS_V = 962 * MiB, WS_F = 1106 * MiB;
constexpr size_t WS_G = 674 * MiB;
constexpr size_t WS_HID = 674 * MiB;
constexpr size_t WS_C1 = 674 * MiB;
constexpr size_t WS_C2 = 962 * MiB;
constexpr size_t WS_OG = 1194 * MiB;
constexpr size_t WS_MA = 866 * MiB;
constexpr size_t WS_X1H = 1194 * MiB;
constexpr size_t WS_END = 1434 * MiB;
static_assert(WS_G + (size_t)24576 * 8192 <= WS_MA && WS_MA + (size_t)24576 * 4096 <= WS_OG, "ws map ma");
static_assert(WS_X1H + (size_t)24576 * 4096 * 2 <= WS_END, "ws map x1h");
static_assert(WS_W8 + (size_t)17408 * D <= WS_WF && WS_WF + (size_t)1024 * D * 2 <= WS_WAU && WS_WGU + (size_t)NGU * D * 2 <= WS_WD && WS_WD + (size_t)D * FF * 2 <= WS_H && WS_H + (size_t)M * D * 2 <= WS_Q, "ws map 1");
static_assert(WS_F + (size_t)4 * M * 256 * 2 <= WS_OG && WS_HID + (size_t)M * FF * 2 <= WS_OG && WS_G + (size_t)M * NGATE * 2 <= WS_F && WS_OG + (size_t)M * AW * 2 <= WS_H8 && WS_H8 + (size_t)M * D <= WS_END, "ws map 2");
constexpr size_t DO_Z = 0, DO_A1 = 96 * MiB, DO_A2 = 192 * MiB, DO_FOUR = 0, DO_ATTN = 336 * MiB;
constexpr int CW_BAR = 4096;

constexpr int RING_OFF = 0, RING_BYTES = 131072;
constexpr int LDSCTL_OFF = RING_BYTES, MISC_OFF = LDSCTL_OFF + 320;
constexpr int LDS_BYTES = 147456;

#define GAS __attribute__((address_space(1)))
#define LAS __attribute__((address_space(3)))
typedef unsigned short bf16;
typedef unsigned v4u __attribute__((ext_vector_type(4)));
typedef unsigned v2u __attribute__((ext_vector_type(2)));
typedef float f32x4 __attribute__((ext_vector_type(4)));
typedef short bf16x8 __attribute__((ext_vector_type(8)));
typedef GAS unsigned gu32;
#define RLX_AGENT __ATOMIC_RELAXED, __HIP_MEMORY_SCOPE_AGENT
#define LDS_WAIT() asm volatile("s_waitcnt lgkmcnt(0)" ::: "memory")
__device__ __forceinline__ unsigned f2bf(float f) { unsigned u = __builtin_bit_cast(unsigned, f); return (u + 0x7fffu + ((u >> 16) & 1u)) >> 16; }
__device__ __forceinline__ unsigned pk2(float lo, float hi) { return f2bf(lo) | (f2bf(hi) << 16); }
__device__ __forceinline__ float bfl(unsigned w) { return __uint_as_float(w << 16); }
__device__ __forceinline__ float bfh(unsigned w) { return __uint_as_float(w & 0xffff0000u); }
#define XB_TMO      128
#define XB_XCNT(j)  (256  + 64 * (j))
#define XB_XSUB(j)  (1280 + 64 * (j))
#define XB_XGEN(j)  (2304 + 64 * (j))
#define XB_TOP      3328
#define XB_TOPGEN   3392
#define XCD_BAR_WORDS 3456
#define XB_SPIN_CAP (1u << 18)

__device__ __forceinline__ unsigned xb_ld(unsigned* p)              { return __hip_atomic_load(p, __ATOMIC_RELAXED, __HIP_MEMORY_SCOPE_AGENT); }
__device__ __forceinline__ unsigned xb_add(unsigned* p, unsigned v) { return __hip_atomic_fetch_add(p, v, __ATOMIC_RELAXED, __HIP_MEMORY_SCOPE_AGENT); }
__device__ __forceinline__ unsigned xb_xcc_id() { return (unsigned)__builtin_amdgcn_s_getreg((3 << 11) | 20) & 0xFu; }
#define XB_SPIN(cond, bar) do { unsigned _sp = 0; while (cond) { __builtin_amdgcn_s_sleep(1); \
    if ((++_sp & 255u) == 0u) { if (xb_ld(&(bar)[XB_TMO])) break; if (_sp > XB_SPIN_CAP) { atomicAdd(&(bar)[XB_TMO], 1u); break; } } } } while (0)

struct XcdBarrier {
    unsigned* bar; unsigned x;
    volatile LAS unsigned* st;
};

__device__ __forceinline__ XcdBarrier xcd_barrier_post(unsigned* bar, volatile LAS unsigned* st, bool t0) {
    XcdBarrier b; b.bar = bar; b.x = xb_xcc_id(); b.st = st;
    if (t0) (void)xb_add(&bar[XB_XCNT(b.x)], 1u);
    return b;
}
__device__ __forceinline__ void xcd_barrier_complete(unsigned* bar, unsigned x, unsigned& nloc, unsigned& nx) {
    const unsigned G = gridDim.x * gridDim.y * gridDim.z;
    unsigned sum, cnt, mine, sp = 0u;
    for (;;) {
        sum = 0u; cnt = 0u; mine = 0u;
#pragma unroll
        for (unsigned j = 0; j < 16; ++j) { const unsigned c = xb_ld(&bar[XB_XCNT(j)]); sum += c; cnt += (c > 0u) ? 1u : 0u; mine = (j == x) ? c : mine; }
        if (sum == G) break;
        __builtin_amdgcn_s_sleep(1);
        if ((++sp & 255u) == 0u) { if (xb_ld(&bar[XB_TMO])) break; if (sp > XB_SPIN_CAP) { atomicAdd(&bar[XB_TMO], 1u); break; } }
    }
    nloc = mine > 0u ? mine : 1u; nx = cnt > 0u ? cnt : 1u;
}

__device__ __forceinline__ void xcd_barrier(const XcdBarrier& b, bool t0) {
    asm volatile("s_waitcnt vmcnt(0)" ::: "memory");
    __syncthreads();
    if (t0) {
        unsigned* bar = b.bar;
        __builtin_amdgcn_s_waitcnt(0);
        unsigned nloc = b.st[0], nx = b.st[1];
        if (nloc == 0u) { xcd_barrier_complete(bar, b.x, nloc, nx); b.st[0] = nloc; b.st[1] = nx; }
        const unsigned old = xb_add(&bar[XB_XSUB(b.x)], 1u);
        const unsigned gen = old / nloc;
        if (old + 1u == (gen + 1u) * nloc) {
            __builtin_amdgcn_fence(__ATOMIC_RELEASE, "agent");
            asm volatile("s_waitcnt vmcnt(0)" ::: "memory");
            const unsigned og = xb_add(&bar[XB_TOP], 1u);
            const unsigned tg = og / nx;
            if (og + 1u == (tg + 1u) * nx) xb_add(&bar[XB_TOPGEN], 1u);
            else XB_SPIN(xb_ld(&bar[XB_TOPGEN]) == tg, bar);
            __builtin_amdgcn_fence(__ATOMIC_ACQUIRE, "agent");
            xb_add(&bar[XB_XGEN(b.x)], 1u);
            asm volatile("s_waitcnt vmcnt(0)" ::: "memory");
        } else {
            XB_SPIN(xb_ld(&bar[XB_XGEN(b.x)]) == gen, bar);
            __builtin_amdgcn_fence(__ATOMIC_ACQUIRE, "agent");
            asm volatile("s_waitcnt vmcnt(0)" ::: "memory");
        }
    }
    __syncthreads();
}

struct Args { const float* in[17]; float* out; unsigned char* ws; int ph_lo, ph_hi; };
struct Frame {
    LAS unsigned char* lds;
    int tid, lane, wave, gw, NGW;
    unsigned char* ws; unsigned char* dout;
};
__device__ __forceinline__ float wave_sum(float v) {
#pragma unroll
    for (int o = 1; o < 64; o <<= 1) v += __shfl_xor(v, o);
    return v;
}
__device__ __forceinline__ void p0_mod_partials(Frame& F, const Args& A) {
    LAS float* sc = (LAS float*)(F.lds + RING_OFF);
    for (int i = F.tid; i < 2 * D; i += NWAVES * 64) { const float c = i < D ? A.in[2][i] : A.in[3][i - D]; sc[i] = c / (1.0f + expf(-c)); }
    __syncthreads();
    const float* wada = A.in[4]; float* modp = (float*)(F.ws + WS_MODP);
    for (int it = F.gw; it < 64 * 96; it += F.NGW) { const int kk = it / 96, cc = it % 96;
        const f32x4* wp = (const f32x4*)(wada + (size_t)(kk * 64) * (6 * D) + cc * 256) + F.lane;
        f32x4 a0 = {0.f, 0.f, 0.f, 0.f}, a1 = {0.f, 0.f, 0.f, 0.f};
#pragma unroll 16
        for (int k = 0; k < 64; ++k) { const f32x4 w = __builtin_nontemporal_load(wp + (size_t)k * (6 * D / 4)); const float s0 = sc[kk * 64 + k], s1 = sc[D + kk * 64 + k]; a0 += w * s0; a1 += w * s1; }
        ((f32x4*)(modp + (size_t)(kk * 2 + 0) * (6 * D) + cc * 256))[F.lane] = a0;
        ((f32x4*)(modp + (size_t)(kk * 2 + 1) * (6 * D) + cc * 256))[F.lane] = a1;
    }
    __syncthreads();
}
__device__ __forceinline__ unsigned pk4_fp8(float a, float b, float c, float d) { int w = 0; w = __builtin_amdgcn_cvt_pk_fp8_f32(a, b, w, false); w = __builtin_amdgcn_cvt_pk_fp8_f32(c, d, w, true); return (unsigned)w; }
template <int MODE> __device__ __forceinline__ int wt_row(int n) {
    if (MODE == 1) { const int d = n & 127;
        return (n & ~255) + 128 * ((d >> 2) & 1) + 32 * (2 * ((n >> 7) & 1) + ((d >> 5) & 1)) + 8 * ((d >> 3) & 3) + 4 * (d >> 6) + (d & 3); }
    if (MODE == 2 || MODE == 3) { const int c = n & 127;
        return 2 * (n & ~127) + 128 * ((c >> 2) & 1) + 32 * (c >> 5) + 8 * ((c >> 3) & 3) + (c & 3) + (MODE == 3 ? 4 : 0); }
    if (MODE == 4) { const int c = n & 255;
        return (n & ~255) + 128 * ((c >> 3) & 1) + 32 * (c >> 6) + 8 * ((c >> 4) & 3) + (c & 7); }
    return n;
}
template <int MODE> __device__ __forceinline__ void p0_transpose_item(const float* W, int K, int N, bf16* WT, int row_off, LAS float* scr, int item, int lane, float ws_ = 1.f) {
    const int nblk = N / 16, kb = item / nblk, nb = item % nblk, k0 = 128 * kb, n0 = 16 * nb;
    float ld_[32];
#pragma unroll
    for (int i = 0; i < 32; ++i) ld_[i] = W[(size_t)(k0 + 4 * i + (lane >> 4)) * N + n0 + (lane & 15)];
#pragma unroll
    for (int i = 0; i < 32; ++i) scr[(4 * i + (lane >> 4)) * 17 + (lane & 15)] = ld_[i];
    LDS_WAIT(); asm volatile("" ::: "memory");
    const int c = lane & 15;
#pragma unroll
    for (int j = 0; j < 4; ++j) { const int n = (lane >> 4) + 4 * j; const LAS float* s = scr + (8 * c) * 17 + n;
        v4u o; o.x = pk2(ws_ * s[0 * 17], ws_ * s[1 * 17]); o.y = pk2(ws_ * s[2 * 17], ws_ * s[3 * 17]); o.z = pk2(ws_ * s[4 * 17], ws_ * s[5 * 17]); o.w = pk2(ws_ * s[6 * 17], ws_ * s[7 * 17]);
        *(v4u*)(WT + (size_t)(row_off + wt_row<MODE>(n0 + n)) * K + k0 + 8 * c) = o; }
    LDS_WAIT(); asm volatile("" ::: "memory");
}
template <int MODE, bool KP = false> __device__ __forceinline__ void p0_transpose_item8(const float* W, int K, int N, unsigned char* WT, int row_off, LAS float* scr, int item, int lane, float ws_ = 64.f) {
    const int nblk = N / 16, kb = item / nblk, nb = item % nblk, k0 = 128 * kb, n0 = 16 * nb;
    float ld_[32];
#pragma unroll
    for (int i = 0; i < 32; ++i) ld_[i] = W[(size_t)(k0 + 4 * i + (lane >> 4)) * N + n0 + (lane & 15)];
#pragma unroll
    for (int i = 0; i < 32; ++i) scr[(4 * i + (lane >> 4)) * 17 + (lane & 15)] = ld_[i];
    LDS_WAIT(); asm volatile("" ::: "memory");
    const int c = lane & 15;
#pragma unroll
    for (int j = 0; j < 4; ++j) { const int n = (lane >> 4) + 4 * j; const LAS float* s = scr + (8 * c) * 17 + n;
        v2u o; o.x = pk4_fp8(ws_ * s[0 * 17], ws_ * s[1 * 17], ws_ * s[2 * 17], ws_ * s[3 * 17]); o.y = pk4_fp8(ws_ * s[4 * 17], ws_ * s[5 * 17], ws_ * s[6 * 17], ws_ * s[7 * 17]);
        unsigned char* dp = WT + (size_t)(row_off + wt_row<MODE>(n0 + n)) * K + k0;
        if constexpr (KP) { const int pos = 32 * (c >> 2) + 16 * (c & 1) + 4 * ((c >> 1) & 1);
            *(unsigned*)(dp + pos) = o.x; *(unsigned*)(dp + pos + 8) = o.y; }
        else *(v2u*)(dp + 8 * c) = o; }
    LDS_WAIT(); asm volatile("" ::: "memory");
}
template <int PART> __device__ __forceinline__ void p0_weights(Frame& F, const Args& A, int gw_ = -1, int ngw_ = 0) {
    LAS float* scr = (LAS float*)(F.lds + RING_OFF + F.wave * 16384);
    unsigned char* w8 = F.ws + WS_W8; bf16* wf = (bf16*)(F.ws + WS_WF); bf16* wau = (bf16*)(F.ws + WS_WAU); bf16* wfu = (bf16*)(F.ws + WS_WFU); bf16* wmix = (bf16*)(F.ws + WS_WMIX); bf16* wgu = (bf16*)(F.ws + WS_WGU); bf16* wd = (bf16*)(F.ws + WS_WD);
    constexpr int I_IN = (D / 128) * (INW / 16), I_AU = (1024 / 128) * (D / 16), I_MIX = (D / 128) * (D / 16), I_G = (D / 128) * (FF / 16), I_D = (FF / 128) * (D / 16);
    constexpr int NITEMS = I_IN + 2 * I_AU + I_MIX + 2 * I_G + I_D;
    constexpr int P3_ITEMS = 8192;
    constexpr int IT_LO = PART == 0 ? 0 : (PART == 1 ? NITEMS - I_D : NITEMS - I_D - P3_ITEMS), IT_HI = PART == 0 ? NITEMS - I_D - P3_ITEMS : (PART == 1 ? NITEMS : NITEMS - I_D);
    const int gw0 = gw_ >= 0 ? gw_ : F.gw, ngw0 = gw_ >= 0 ? ngw_ : F.NGW;
    for (int it = IT_LO + gw0; it < IT_HI; it += ngw0) {
        int r = it;
        if (r < I_IN) { const int nb = (r % (INW / 16)) >> 1;
            if (nb < 6144 / 32) p0_transpose_item8<1>(A.in[6], D, INW, w8, 0, scr, r, F.lane); else if (nb < 9216 / 32) p0_transpose_item8<4>(A.in[6], D, INW, w8, 0, scr, r, F.lane);
            else if (nb < 10240 / 32) p0_transpose_item<4>(A.in[6], D, INW, wf, -9216, scr, r, F.lane); else p0_transpose_item8<4>(A.in[6], D, INW, w8, -1024, scr, r, F.lane, 64.f * 1.4426950408889634f);
            continue; } r -= I_IN;
        if (r < I_AU) { p0_transpose_item8<4, true>(A.in[7], 1024, D, (unsigned char*)wau, 0, scr, r, F.lane, 32.f); continue; } r -= I_AU;
        if (r < I_AU) { p0_transpose_item<4>(A.in[8], 1024, D, wfu, 0, scr, r, F.lane, 0.00390625f);     continue; } r -= I_AU;
        if (r < I_MIX) { p0_transpose_item<4>(A.in[9], D, D, wmix, 0, scr, r, F.lane); continue; } r -= I_MIX;
        if (r < I_G) { p0_transpose_item8<2>(A.in[12], D, FF, (unsigned char*)wgu, 0, scr, r, F.lane, 64.f * 1.4426950408889634f)    ; continue; } r -= I_G;
        if (r < I_G) { p0_transpose_item8<3>(A.in[13], D, FF, (unsigned char*)wgu, 0, scr, r, F.lane, 64.f); continue; } r -= I_G;
        p0_transpose_item8<4>(A.in[14], FF, D, (unsigned char*)wd, 0, scr, r, F.lane, 128.f);
    }
}
__device__ __forceinline__ void p0_tables(Frame& F) {
    const int gt = F.gw * 64 + F.lane, NGT = F.NGW * 64;
    unsigned* rope = (unsigned*)(F.ws + WS_ROPE);
    for (int i = gt; i < S0 * 64; i += NGT) { const int pos = i >> 6, d = i & 63;
        const float inv = powf(10000.0f, -(float)d / 64.0f); const float ang = (float)pos * inv;
        const double tr = (double)ang * 0.15915494309189535; const float fr_ = (float)(tr - floor(tr));
        float sn, cs; sincospif(2.0f * fr_, &sn, &cs); rope[(size_t)i] = pk2(cs, sn); }
    { float* tw = (float*)(F.ws + WS_TW); for (int i = gt; i < S0; i += NGT) { float sn, cs; sincospif((float)i * (2.0f / (float)S0), &sn, &cs); tw[2 * i] = cs; tw[2 * i + 1] = sn; } }
    bf16* c256 = (bf16*)(F.ws + WS_C256); bf16* d128 = (bf16*)(F.ws + WS_D128); bf16* d64 = (bf16*)(F.ws + WS_D64);
    for (int i = gt; i < 512 * 256; i += NGT) { const int r = i >> 8, c = i & 255, ri = r >> 8, cp = r & 255;
        float sn, cs; sincospif((float)((c * cp) & 255) * (1.0f / 128.0f), &sn, &cs); c256[i] = (bf16)f2bf(ri ? -sn : cs); }
    for (int i = gt; i < 256 * 256; i += NGT) { const int r = i >> 8, c = i & 255, ro = r >> 7, ka = r & 127, ri = c >> 7, sh = c & 127;
        float sn, cs; sincospif((float)((ka * sh) & 127) * (1.0f / 64.0f), &sn, &cs);
        d128[i] = (bf16)f2bf(ro == ri ? cs : (ro == 0 ? sn : -sn));
        float v = 0.f; if (r < 64 && sh < 64) { float s2, c2; sincospif((float)((r * sh) & 63) * (1.0f / 32.0f), &s2, &c2); v = ri ? s2 : c2; }
        d64[i] = (bf16)f2bf(v); }
}
__device__ __forceinline__ void p1_mod_reduce(Frame& F, const Args& A) {
    const float* modp = (const float*)(F.ws + WS_MODP); float* mod = (float*)(F.ws + WS_MOD); const float* bada = A.in[5];
    for (int i = F.gw * 64 + F.lane; i < 2 * 6 * D; i += F.NGW * 64) { const int b = i / (6 * D), col = i % (6 * D); float s = bada[col];
        for (int kk = 0; kk < 64; ++kk) s += modp[(size_t)(kk * 2 + b) * (6 * D) + col];
        mod[i] = s; }
}
__device__ __forceinline__ void row_stats(const f32x4 (&v)[16], float& mean, float& rstd) {
    float s = 0.f;
#pragma unroll
    for (int j = 0; j < 16; ++j) s += (v[j][0] + v[j][1]) + (v[j][2] + v[j][3]);
    mean = wave_sum(s) * (1.0f / D); float q = 0.f;
#pragma unroll
    for (int j = 0; j < 16; ++j) { const f32x4 d = v[j] - mean; q += (d[0] * d[0] + d[1] * d[1]) + (d[2] * d[2] + d[3] * d[3]); }
    rstd = 1.0f / sqrtf(wave_sum(q) * (1.0f / D) + LN_EPS);
}
__device__ __forceinline__ void p2_ln_mod(Frame& F, const Args& A) {
    const float* mod = (const float*)(F.ws + WS_MOD); bf16* H = (bf16*)(F.ws + WS_H);
    f32x4 nx[16];
    { const int row = F.gw; const f32x4* xr = (const f32x4*)(row >= S0 ? A.in[1] + (size_t)(row - S0) * D : A.in[0] + (size_t)row * D) + F.lane;
#pragma unroll
      for (int j = 0; j < 16; ++j) nx[j] = __builtin_nontemporal_load(xr + 64 * j); }
    asm volatile("" ::: "memory");
    p0_tables(F);
    for (int row = F.gw; row < M; row += F.NGW) { const int b = row >= S0;
        const f32x4* sh = (const f32x4*)(mod + b * 6 * D) + F.lane; const f32x4* sc = (const f32x4*)(mod + b * 6 * D + D) + F.lane;
        f32x4 v[16];
#pragma unroll
        for (int j = 0; j < 16; ++j) v[j] = nx[j];
        { const int rn = row + F.NGW; if (rn < M) { const f32x4* xr = (const f32x4*)(rn >= S0 ? A.in[1] + (size_t)(rn - S0) * D : A.in[0] + (size_t)rn * D) + F.lane;
#pragma unroll
            for (int j = 0; j < 16; ++j) nx[j] = __builtin_nontemporal_load(xr + 64 * j); } }
        float mean, rstd; row_stats(v, mean, rstd);
        v2u* o = (v2u*)(H + (size_t)row * D) + F.lane; unsigned* o8 = (unsigned*)(F.ws + WS_H8 + (size_t)row * D) + F.lane;
#pragma unroll
        for (int j = 0; j < 16; ++j) { const f32x4 y = (v[j] - mean) * rstd * (sc[64 * j] + 1.0f) + sh[64 * j]; v2u w; w.x = pk2(y[0], y[1]); w.y = pk2(y[2], y[3]); o[64 * j] = w; o8[64 * j] = pk4_fp8(y[0], y[1], y[2], y[3]); }
    }
}
typedef _Float16 h16x2 __attribute__((ext_vector_type(2)));
__device__ __forceinline__ unsigned pk2_h(float a, float b) { typedef float f2_ __attribute__((ext_vector_type(2))); const h16x2 h = __builtin_convertvector((f2_){a, b}, h16x2); return __builtin_bit_cast(unsigned, h); }
__device__ __forceinline__ float hlo(unsigned w) { return (float)__builtin_bit_cast(h16x2, w)[0]; }
__device__ __forceinline__ float hhi(unsigned w) { return (float)__builtin_bit_cast(h16x2, w)[1]; }
__device__ __forceinline__ void p13_ln1(Frame& F, const Args& A) {
    const float* mod = (const float*)(F.ws + WS_MOD); bf16* H = (bf16*)(F.ws + WS_H);
    f32x4 nx[16];
    { const int row = F.gw; const f32x4* xin = (const f32x4*)(row >= S0 ? A.in[1] + (size_t)(row - S0) * D : A.in[0] + (size_t)row * D) + F.lane;
#pragma unroll
      for (int j = 0; j < 16; ++j) nx[j] = __builtin_nontemporal_load(xin + 64 * j); }
    for (int row = F.gw; row < M; row += F.NGW) { const int b = row >= S0;
        v2u* xr = (v2u*)(F.ws + WS_X1H + (size_t)row * D * 2) + F.lane;
        const v2u* c1 = (const v2u*)(F.ws + WS_C1 + (size_t)row * D * 2) + F.lane;
        const f32x4* g1 = (const f32x4*)A.in[10] + F.lane; const f32x4* b1 = (const f32x4*)A.in[11] + F.lane;
        const f32x4* sh = (const f32x4*)(mod + b * 6 * D + 3 * D) + F.lane; const f32x4* sc = (const f32x4*)(mod + b * 6 * D + 4 * D) + F.lane;
        f32x4 v[16];
#pragma unroll
        for (int j = 0; j < 16; ++j) { const v2u c = __builtin_nontemporal_load(c1 + 64 * j); v[j] = nx[j] * ALPHA + (f32x4){bfl(c.x), bfh(c.x), bfl(c.y), bfh(c.y)}; }
        { const int rn = row + F.NGW; if (rn < M) { const f32x4* xin = (const f32x4*)(rn >= S0 ? A.in[1] + (size_t)(rn - S0) * D : A.in[0] + (size_t)rn * D) + F.lane;
#pragma unroll
            for (int j = 0; j < 16; ++j) nx[j] = __builtin_nontemporal_load(xin + 64 * j); } }
        float mean, rstd; row_stats(v, mean, rstd);
#pragma unroll
        for (int j = 0; j < 16; ++j) { v[j] = (v[j] - mean) * rstd * g1[64 * j] + b1[64 * j]; v2u w; w.x = pk2_h(v[j][0], v[j][1]); w.y = pk2_h(v[j][2], v[j][3]); __builtin_nontemporal_store(w, xr + 64 * j); }
        row_stats(v, mean, rstd);
        unsigned* o8 = (unsigned*)((unsigned char*)H + (size_t)row * D) + F.lane;
#pragma unroll
        for (int j = 0; j < 16; ++j) { const f32x4 y = (v[j] - mean) * rstd * (sc[64 * j] + 1.0f) + sh[64 * j]; o8[64 * j] = pk4_fp8(y[0], y[1], y[2], y[3]); }
    }
}
__device__ __forceinline__ void p16_ln2(Frame& F, const Args& A) {
    float* out = (float*)F.dout;
    v2u nc[16], nxh[16];
    { const int row = F.gw; const v2u* c2 = (const v2u*)(F.ws + WS_C2 + (size_t)row * D * 2) + F.lane; const v2u* x1 = (const v2u*)(F.ws + WS_X1H + (size_t)row * D * 2) + F.lane;
#pragma unroll
      for (int j = 0; j < 16; ++j) { nc[j] = __builtin_nontemporal_load(c2 + 64 * j); nxh[j] = __builtin_nontemporal_load(x1 + 64 * j); } }
    for (int row = F.gw; row < M; row += F.NGW) {
        f32x4* xr = (f32x4*)(out + (size_t)row * D) + F.lane;
        const f32x4* g2 = (const f32x4*)A.in[15] + F.lane; const f32x4* b2 = (const f32x4*)A.in[16] + F.lane;
        f32x4 v[16];
#pragma unroll
        for (int j = 0; j < 16; ++j) { const v2u c = nc[j], x = nxh[j]; v[j] = (f32x4){hlo(x.x), hhi(x.x), hlo(x.y), hhi(x.y)} * ALPHA + (f32x4){bfl(c.x), bfh(c.x), bfl(c.y), bfh(c.y)}; }
        { const int rn = row + F.NGW; if (rn < M) { const v2u* c2 = (const v2u*)(F.ws + WS_C2 + (size_t)rn * D * 2) + F.lane; const v2u* x1 = (const v2u*)(F.ws + WS_X1H + (size_t)rn * D * 2) + F.lane;
#pragma unroll
            for (int j = 0; j < 16; ++j) { nc[j] = __builtin_nontemporal_load(c2 + 64 * j); nxh[j] = __builtin_nontemporal_load(x1 + 64 * j); } } }
        float mean, rstd; row_stats(v, mean, rstd);
#pragma unroll
        for (int j = 0; j < 16; ++j) __builtin_nontemporal_store((v[j] - mean) * rstd * g2[64 * j] + b2[64 * j], xr + 64 * j);
    }
}
constexpr int VT_LD = 136;
typedef short v4s_t __attribute__((ext_vector_type(4)));
__device__ __forceinline__ void attn_unit(const bf16* __restrict__ Q, const bf16* __restrict__ Kb, const unsigned char* __restrict__ V, bf16* __restrict__ OG, float* __restrict__ LSE, int unit, int lane, LAS bf16* vt) {
    const int gh = unit / 768; int u = unit - gh * 768;
    const int dsh = 2 * (gh >> 3);
    int seq_off = 0, S = S0; if (u >= 512) { u -= 512; seq_off = S0; S = S1; }
    const int L = S >> dsh, cpc = L >> 5;
    const int r = u / cpc, ch = u - r * cpc;
    const int colbase = gh * 128;
    const int i = lane & 15, h = lane >> 4;
    const int l0 = 32 * ch - 64;
    size_t qrow[2]; bf16x8 qf[2][4];
#pragma unroll
    for (int qt = 0; qt < 2; ++qt) { qrow[qt] = (size_t)seq_off + (size_t)(((32 * ch + 16 * qt + i) << dsh) + r); const bf16* qp = Q + qrow[qt] * AW + colbase + 8 * h;
#pragma unroll
        for (int ks = 0; ks < 4; ++ks) qf[qt][ks] = *(const bf16x8*)(qp + 32 * ks); }
    f32x4 sc[2][10];
    constexpr int KD = 5;
    bf16x8 kf[KD][4];
#define ATT_KLOAD(t_, dst_) do { int lk_ = l0 + 16 * (t_) + i; lk_ = lk_ < 0 ? 0 : (lk_ > L - 1 ? L - 1 : lk_); \
        const bf16* kp_ = Kb + ((size_t)seq_off + (size_t)((lk_ << dsh) + r)) * AW + colbase + 8 * h; \
        _Pragma("unroll") for (int ks = 0; ks < 4; ++ks) dst_[ks] = *(const bf16x8*)(kp_ + 32 * ks); } while (0)
#pragma unroll
    for (int t = 0; t < KD; ++t) ATT_KLOAD(t, kf[t]);
    asm volatile("" ::: "memory");
#pragma unroll
    for (int t = 0; t < 10; ++t) {
#pragma unroll
        for (int qt = 0; qt < 2; ++qt) { f32x4 a = {0.f, 0.f, 0.f, 0.f};
#pragma unroll
            for (int ks = 0; ks < 4; ++ks) a = __builtin_amdgcn_mfma_f32_16x16x32_bf16(kf[t % KD][ks], qf[qt][ks], a, 0, 0, 0);
            sc[qt][t] = a; }
        if (t + KD < 10) { ATT_KLOAD(t + KD, kf[t % KD]); asm volatile("" ::: "memory"); } }
#undef ATT_KLOAD
    v2u vv[8];
#define ATT_VLOAD(c_, dst_) do { _Pragma("unroll") for (int it = 0; it < 8; ++it) { int lk_ = l0 + 32 * (c_) + h + 4 * it; lk_ = lk_ < 0 ? 0 : (lk_ > L - 1 ? L - 1 : lk_); \
        dst_[it] = *(const v2u*)(V + ((size_t)seq_off + (size_t)((lk_ << dsh) + r)) * AW + colbase + 8 * i); } } while (0)
    ATT_VLOAD(0, vv);
    asm volatile("" ::: "memory");
    float mx[2], sum[2];
#pragma unroll
    for (int qt = 0; qt < 2; ++qt) { float m_ = -3.0e38f;
#pragma unroll
        for (int t = 0; t < 10; ++t)
#pragma unroll
            for (int rg = 0; rg < 4; ++rg) { const int c = 4 * h + rg, rel = 16 * t + c - 16 * qt - i, lk = l0 + 16 * t + c;
                const bool valid = (lk >= 0) && (lk < L) && (rel >= 0) && (rel <= 128);
                const float s_ = valid ? sc[qt][t][rg] : -1.0e30f; sc[qt][t][rg] = s_; m_ = fmaxf(m_, s_); }
        m_ = fmaxf(m_, __shfl_xor(m_, 16)); m_ = fmaxf(m_, __shfl_xor(m_, 32)); mx[qt] = m_;
        float su = 0.f;
#pragma unroll
        for (int t = 0; t < 10; ++t)
#pragma unroll
            for (int rg = 0; rg < 4; ++rg) { const float p = __builtin_amdgcn_exp2f(sc[qt][t][rg] - m_); sc[qt][t][rg] = p; su += p; }
        su += __shfl_xor(su, 16); su += __shfl_xor(su, 32); sum[qt] = su; }
    f32x4 o[2][8];
#pragma unroll
    for (int qt = 0; qt < 2; ++qt)
#pragma unroll
        for (int dc = 0; dc < 8; ++dc) o[qt][dc] = (f32x4){0.f, 0.f, 0.f, 0.f};
#pragma unroll
    for (int kk = 0; kk < 5; ++kk) {
#pragma unroll
        for (int it = 0; it < 8; ++it) { const v2u r8 = vv[it];
            const pg8::cvt_f32x2 a0 = __builtin_amdgcn_cvt_pk_f32_fp8((int)r8.x, false), a1 = __builtin_amdgcn_cvt_pk_f32_fp8((int)r8.x, true), a2 = __builtin_amdgcn_cvt_pk_f32_fp8((int)r8.y, false), a3 = __builtin_amdgcn_cvt_pk_f32_fp8((int)r8.y, true);
            v4u wv; wv.x = pk2(a0[0], a0[1]); wv.y = pk2(a1[0], a1[1]); wv.z = pk2(a2[0], a2[1]); wv.w = pk2(a3[0], a3[1]);
            *(LAS v4u*)(vt + (h + 4 * it) * VT_LD + 8 * i) = wv; }
        if (kk + 1 < 5) { ATT_VLOAD(kk + 1, vv); asm volatile("" ::: "memory"); }
        bf16x8 pf[2];
#pragma unroll
        for (int qt = 0; qt < 2; ++qt)
#pragma unroll
            for (int j = 0; j < 8; ++j) pf[qt][j] = (short)f2bf(sc[qt][2 * kk + (j >> 2)][j & 3]);
#pragma unroll
        for (int dc = 0; dc < 8; ++dc) {
            const LAS bf16* rp = vt + (4 * h + (i >> 2)) * VT_LD + 16 * dc + 4 * (i & 3);
            const v4s_t lo = __builtin_amdgcn_ds_read_tr16_b64_v4i16((LAS v4s_t*)rp), hi = __builtin_amdgcn_ds_read_tr16_b64_v4i16((LAS v4s_t*)(rp + 16 * VT_LD));
            const bf16x8 vf = __builtin_shufflevector(lo, hi, 0, 1, 2, 3, 4, 5, 6, 7);
#pragma unroll
            for (int qt = 0; qt < 2; ++qt) o[qt][dc] = __builtin_amdgcn_mfma_f32_16x16x32_bf16(vf, pf[qt], o[qt][dc], 0, 0, 0); }
    }
#undef ATT_VLOAD
#pragma unroll
    for (int qt = 0; qt < 2; ++qt) { const float inv = 0.0625f / sum[qt]; bf16* op = OG + qrow[qt] * AW + colbase + 8 * h;
#pragma unroll
        for (int s2 = 0; s2 < 4; ++s2) { v4u w; w.x = pk2(o[qt][2 * s2][0] * inv, o[qt][2 * s2][1] * inv); w.y = pk2(o[qt][2 * s2][2] * inv, o[qt][2 * s2][3] * inv);
            w.z = pk2(o[qt][2 * s2 + 1][0] * inv, o[qt][2 * s2 + 1][1] * inv); w.w = pk2(o[qt][2 * s2 + 1][2] * inv, o[qt][2 * s2 + 1][3] * inv); *(v4u*)(op + 32 * s2) = w; }
        if (h == 0) LSE[qrow[qt] * 24 + gh] = (mx[qt] + __log2f(sum[qt])) * 0.6931471805599453f; }
}
__device__ __forceinline__ void p_attention(Frame& F) {
    const bf16* Q = (const bf16*)(F.ws + WS_Q); const bf16* Kb = (const bf16*)(F.ws + WS_K); const unsigned char* V = F.ws + WS_V;
    bf16* OG = (bf16*)(F.ws + WS_OG); float* LSE = (float*)(F.ws + WS_LSE);
    LAS bf16* vt = (LAS bf16*)(F.lds + RING_OFF + F.wave * (32 * VT_LD * 2));
    for (int unit = F.gw; unit < 24 * 768; unit += F.NGW) attn_unit(Q, Kb, V, OG, LSE, unit, F.lane, vt);
    __syncthreads();
}
__device__ __forceinline__ void p_combine(Frame& F) {
    const bf16* OG = (const bf16*)(F.ws + WS_OG); const float* LSE = (const float*)(F.ws + WS_LSE); unsigned char* AT = F.dout + DO_ATTN;
    const int hh = F.lane >> 3, cq = F.lane & 7;
    v4u nv[2][3]; float nl[3];
#define PC_LOAD(row_) do { const bf16* p_ = OG + (size_t)(row_) * AW + hh * 128 + cq * 16; \
        _Pragma("unroll") for (int half = 0; half < 2; ++half) _Pragma("unroll") for (int g_ = 0; g_ < 3; ++g_) nv[half][g_] = __builtin_nontemporal_load((const v4u*)(p_ + 1024 * g_ + 8 * half)); \
        _Pragma("unroll") for (int g_ = 0; g_ < 3; ++g_) nl[g_] = LSE[(size_t)(row_) * 24 + 8 * g_ + hh]; } while (0)
    if (F.gw < M) PC_LOAD(F.gw);
    for (int row = F.gw; row < M; row += F.NGW) {
        const float l0 = nl[0], l1 = nl[1], l2 = nl[2];
        v4u cv[2][3];
#pragma unroll
        for (int half = 0; half < 2; ++half)
#pragma unroll
            for (int g_ = 0; g_ < 3; ++g_) cv[half][g_] = nv[half][g_];
        if (row + F.NGW < M) PC_LOAD(row + F.NGW);
        const float mx = fmaxf(l0, fmaxf(l1, l2)); float w0 = __expf(l0 - mx), w1 = __expf(l1 - mx), w2 = __expf(l2 - mx); const float inv = 1.0f / (w0 + w1 + w2); w0 *= inv; w1 *= inv; w2 *= inv;
        v4u o4;
#pragma unroll
        for (int half = 0; half < 2; ++half) {
            const v4u a = cv[half][0], b = cv[half][1], c = cv[half][2];
            v2u o;
            o.x = pk4_fp8(64.f * (w0 * bfl(a.x) + w1 * bfl(b.x) + w2 * bfl(c.x)), 64.f * (w0 * bfh(a.x) + w1 * bfh(b.x) + w2 * bfh(c.x)), 64.f * (w0 * bfl(a.y) + w1 * bfl(b.y) + w2 * bfl(c.y)), 64.f * (w0 * bfh(a.y) + w1 * bfh(b.y) + w2 * bfh(c.y)));
            o.y = pk4_fp8(64.f * (w0 * bfl(a.z) + w1 * bfl(b.z) + w2 * bfl(c.z)), 64.f * (w0 * bfh(a.z) + w1 * bfh(b.z) + w2 * bfh(c.z)), 64.f * (w0 * bfl(a.w) + w1 * bfl(b.w) + w2 * bfl(c.w)), 64.f * (w0 * bfh(a.w) + w1 * bfh(b.w) + w2 * bfh(c.w)));
            o4[2 * half] = o.x; o4[2 * half + 1] = o.y; }
        *(v4u*)(AT + (size_t)row * 1024 + hh * 128 + cq * 16) = o4;
    }
#undef PC_LOAD
}
__device__ __forceinline__ void tr8x8(const v4u (&in)[8], v4u (&out)[8]) {
    unsigned a[8][8];
#pragma unroll
    for (int e = 0; e < 8; ++e) { a[e][0] = in[e].x & 0xffffu; a[e][1] = in[e].x >> 16; a[e][2] = in[e].y & 0xffffu; a[e][3] = in[e].y >> 16; a[e][4] = in[e].z & 0xffffu; a[e][5] = in[e].z >> 16; a[e][6] = in[e].w & 0xffffu; a[e][7] = in[e].w >> 16; }
#pragma unroll
    for (int q = 0; q < 8; ++q) { out[q].x = a[0][q] | (a[1][q] << 16); out[q].y = a[2][q] | (a[3][q] << 16); out[q].z = a[4][q] | (a[5][q] << 16); out[q].w = a[6][q] | (a[7][q] << 16); }
}

__device__ __forceinline__ int lane_id_now() { int l; asm volatile("v_mbcnt_lo_u32_b32 %0, -1, 0\n\tv_mbcnt_hi_u32_b32 %0, -1, %0" : "=v"(l)); return l; }
__global__ void __launch_bounds__(NWAVES * 64, 2) enc_fwd(Args args) {
    extern __shared__ __attribute__((aligned(16))) unsigned char lds[];
#define HW_SLOT() ((int)__builtin_amdgcn_s_getreg((5 << 11) | 4) & 63)
#define TID() (64 * (int)__builtin_amdgcn_readfirstlane((int)((volatile LAS unsigned char*)((LAS unsigned char*)lds + MISC_OFF + 64))[HW_SLOT()]) + lane_id_now())
    { const int t0 = threadIdx.x; for (int u = t0; u < (LDS_BYTES - LDSCTL_OFF) / 4; u += NWAVES * 64) ((LAS unsigned*)((LAS unsigned char*)lds + LDSCTL_OFF))[u] = 0u; }
    __syncthreads();
    if ((threadIdx.x & 63) == 0) ((volatile LAS unsigned char*)((LAS unsigned char*)lds + MISC_OFF + 64))[HW_SLOT()] = (unsigned char)(threadIdx.x >> 6);
    __syncthreads();
#define MKF() Frame F; { int t_ = TID(); asm volatile("" : "+v"(t_)); F.lds = (LAS unsigned char*)lds; F.tid = t_; F.lane = t_ & 63; F.wave = __builtin_amdgcn_readfirstlane(t_ >> 6); \
        const int G_ = gridDim.x, bx_ = blockIdx.x; const int vcu_ = (G_ % 8 == 0) ? (bx_ % 8) * (G_ / 8) + bx_ / 8 : bx_; F.gw = vcu_ * NWAVES + F.wave; F.NGW = G_ * NWAVES; F.ws = args.ws; F.dout = (unsigned char*)args.out; }
    unsigned* ctl = (unsigned*)(args.ws + WS_CTL);
#if MK_ONE_LAUNCH
    (void)xcd_barrier_post(ctl + CW_BAR, (volatile LAS unsigned*)((LAS unsigned char*)lds + MISC_OFF) + 8, TID() == 0);
#define IN(k) true
#define SEAM(k) do { XcdBarrier b_; b_.bar = (unsigned*)(args.ws + WS_CTL) + CW_BAR; b_.x = xb_xcc_id(); b_.st = (volatile LAS unsigned*)((LAS unsigned char*)lds + MISC_OFF) + 8; xcd_barrier(b_, TID() == 0); } while (0)
#else
    const int lo = args.ph_lo, hi = args.ph_hi;
#define IN(k) (lo <= (k) && (k) < hi)
#define SEAM(k) do { } while (0)
#endif
#define HB ((bf16*)(args.ws + WS_H))
#define WSP(off) (args.ws + (off))
#define DOP(off) ((unsigned char*)args.out + (off))
#define LDSP ((LAS unsigned char*)lds + RING_OFF)
#define GRID_ ((int)gridDim.x)
    const float* const mod = (const float*)(args.ws + WS_MOD);
    float* const out = args.out;

    if (IN(0)) { MKF(); p0_mod_partials(F, args); p0_weights<0>(F, args); } SEAM(0);
    if (IN(1)) { MKF(); p1_mod_reduce(F, args); p0_weights<1>(F, args); } SEAM(1);
    if (IN(2)) { MKF(); p2_ln_mod(F, args); } SEAM(2);
    if (IN(3)) {
        { pg8::Gemm g{(const bf16*)(args.ws + WS_H8), (const bf16*)(args.ws + WS_W8), M, 9216, D}; pg8::StaticOrder S; S.init(M, 9216, GRID_, (int)blockIdx.x);
          pg8::EpiQKVF E{(bf16*)(args.ws + WS_Q), (bf16*)(args.ws + WS_K), (bf16*)(args.ws + WS_V), (bf16*)(args.ws + WS_F), (const float*)(args.ws + WS_ROPE), 0};
          pg8::gemm_phase<pg8::EpiQKVF, pg8::StaticOrder, true, true, true>(LDSP, g, S, E, TID()); }
        { pg8::Gemm g{HB, (const bf16*)(args.ws + WS_WF), M, 1024, D}; pg8::StaticOrder S; S.init(M, 1024, GRID_, ((int)blockIdx.x + GRID_ / 2) % GRID_);
          pg8::EpiQKVF E{(bf16*)(args.ws + WS_Q), (bf16*)(args.ws + WS_K), (bf16*)(args.ws + WS_V), (bf16*)(args.ws + WS_F), (const float*)(args.ws + WS_ROPE), 36};
          pg8::gemm_phase<pg8::EpiQKVF, pg8::StaticOrder, true, true>(LDSP, g, S, E, TID()); }
        if ((int)blockIdx.x < GRID_ / 2) { MKF(); p0_weights<2>(F, args, (int)blockIdx.x * NWAVES + F.wave, (GRID_ / 2) * NWAVES); }
    } SEAM(3);
    if (IN(4)) {
        { MKF(); p_attention(F); }
        { pg8::Gemm g{(const bf16*)(args.ws + WS_C256), (const bf16*)(args.ws + WS_F), 512, 65536, 256}; pg8::DftOrder S; S.init(512, 65536, GRID_, (int)blockIdx.x); S.tsh = 6; S.gjump = (size_t)M * 512 - (size_t)64 * 1024; S.brow_bytes = 128 * 512;
          pg8::EpiA1 E{(bf16*)((unsigned char*)args.out + DO_A1), 6, 7, 0.0625f};
          pg8::gemm_phase<pg8::EpiA1, pg8::DftOrder, false, false>(LDSP, g, S, E, TID()); }
        { pg8::Gemm g{(const bf16*)(args.ws + WS_C256), (const bf16*)(args.ws + WS_F) + (size_t)S0 * 256, 512, 32768, 256}; pg8::DftOrder S; S.init(512, 32768, GRID_, (int)blockIdx.x); S.tsh = 5; S.gjump = (size_t)M * 512 - (size_t)32 * 1024; S.brow_bytes = 64 * 512;
          pg8::EpiA1 E{(bf16*)((unsigned char*)args.out + DO_A1) + (size_t)131072 * 256, 5, 6, 0.0625f};
          pg8::gemm_phase<pg8::EpiA1, pg8::DftOrder, false, false>(LDSP, g, S, E, TID()); }
    } SEAM(4);
    if (IN(6)) {
        { MKF(); p_combine(F); }
        { pg8::Gemm g{(const bf16*)(args.ws + WS_D128), (const bf16*)((unsigned char*)args.out + DO_A1), 256, 196608, 256}; pg8::StaticOrder S; S.init(256, 196608, GRID_, (int)blockIdx.x);
          pg8::EpiTwT E{(bf16*)((unsigned char*)args.out + DO_A2), 0.08838834764831845f, (const float*)(args.ws + WS_TW)};
          pg8::gemm_phase<pg8::EpiTwT, pg8::StaticOrder, false, false>(LDSP, g, S, E, TID()); }
    } SEAM(6);
    if (IN(7)) {
        { pg8::Gemm g{(const bf16*)(args.ws + WS_H8), (const bf16*)(args.ws + WS_W8 + (size_t)9216 * D), M, NGATE, D}; pg8::StaticOrder S; S.init(M, NGATE, GRID_, (int)blockIdx.x);
          pg8::EpiGates E{args.ws + WS_G};
          pg8::gemm_phase<pg8::EpiGates, pg8::StaticOrder, true, true, true>(LDSP, g, S, E, TID()); }
    }
    if (IN(8)) {
        { pg8::Gemm g{(const bf16*)((unsigned char*)args.out + DO_A2), (const bf16*)(args.ws + WS_D128), 131072, 256, 256}; pg8::StaticOrder S; S.init(131072, 256, GRID_, (int)blockIdx.x);
          pg8::EpiFour E{(bf16*)((unsigned char*)args.out + DO_FOUR), 0, 128, 0.08838834764831845f};
          pg8::gemm_phase<pg8::EpiFour, pg8::StaticOrder, true, false>(LDSP, g, S, E, TID()); }
        { pg8::Gemm g{(const bf16*)((unsigned char*)args.out + DO_A2) + (size_t)131072 * 256, (const bf16*)(args.ws + WS_D64), 131072, 256, 256}; pg8::StaticOrder S; S.init(131072, 256, GRID_, (int)blockIdx.x);
          pg8::EpiFour E{(bf16*)((unsigned char*)args.out + DO_FOUR), S0, 64, 0.125f};
          pg8::gemm_phase<pg8::EpiFour, pg8::StaticOrder, true, false>(LDSP, g, S, E, TID()); }
    } SEAM(8);
    if (IN(10)) {
        { pg8::Gemm g{(const bf16*)((unsigned char*)args.out + DO_ATTN), (const bf16*)(args.ws + WS_WAU), M, D, 1024, 0x72727272, 0x79797979}; pg8::StaticOrder S; S.init(M, D, GRID_, (int)blockIdx.x);
          pg8::EpiBranch<0> E{args.ws + WS_G, HB, args.ws + WS_MA};
          pg8::gemm_phase<pg8::EpiBranch<0>, pg8::StaticOrder, true, true, true>(LDSP, g, S, E, TID()); }
        { pg8::Gemm g{(const bf16*)((unsigned char*)args.out + DO_FOUR), (const bf16*)(args.ws + WS_WFU), M, D, 1024}; pg8::StaticOrder S; S.init(M, D, GRID_, (int)blockIdx.x);
          pg8::EpiBranch<1> E{args.ws + WS_G, HB, args.ws + WS_MA};
          pg8::gemm_phase<pg8::EpiBranch<1>, pg8::StaticOrder, true, true>(LDSP, g, S, E, TID()); }
    } SEAM(10);
    if (IN(11)) {
        pg8::Gemm g{HB, (const bf16*)(args.ws + WS_WMIX), M, D, D}; pg8::StaticOrder S; S.init(M, D, GRID_, (int)blockIdx.x);
        pg8::EpiContrib E{(bf16*)(args.ws + WS_C1), mod + 2 * D, mod + 6 * D + 2 * D};
        pg8::gemm_phase<pg8::EpiContrib, pg8::StaticOrder, true, true>(LDSP, g, S, E, TID());
    } SEAM(11);
    if (IN(12)) { MKF(); p13_ln1(F, args); } SEAM(12);
    if (IN(13)) {
        pg8::Gemm g{HB, (const bf16*)(args.ws + WS_WGU), M, NGU, D, 0x79797979, 0x7f7f7f7f}; pg8::StaticOrder S; S.init(M, NGU, GRID_, (int)blockIdx.x);
        pg8::EpiGU E{(unsigned char*)(args.ws + WS_HID)};
        pg8::gemm_phase<pg8::EpiGU, pg8::StaticOrder, true, true, true>(LDSP, g, S, E, TID());
    } SEAM(13);
    if (IN(14)) {
        pg8::Gemm g{(const bf16*)(args.ws + WS_HID), (const bf16*)(args.ws + WS_WD), M, D, FF, 0x78787878, 0x7b7b7b7b}; pg8::StaticOrder S; S.init(M, D, GRID_, (int)blockIdx.x);
        pg8::EpiContrib E{(bf16*)(args.ws + WS_C2), mod + 5 * D, mod + 6 * D + 5 * D};
        pg8::gemm_phase<pg8::EpiContrib, pg8::StaticOrder, true, true, true>(LDSP, g, S, E, TID());
    } SEAM(14);
    if (IN(15)) { MKF(); p16_ln2(F, args); }
#undef IN
#undef SEAM
}

extern "C" void kernel_launch(void* const* d_in, const int* in_sizes, int n_in, void* d_out, int out_size, void* d_ws, size_t ws_size, hipStream_t stream) {
    static int grid = 0;
    if (grid == 0) {
        if (n_in != 17 || out_size != M * D || ws_size < WS_END) { fprintf(stderr, "kernel_launch: unexpected shapes (n_in %d, out %d, ws %zu); nothing launched\n", n_in, out_size, ws_size); grid = -1; return; }
        int dev = 0, cus = 0;
        if (hipGetDevice(&dev) != hipSuccess || hipDeviceGetAttribute(&cus, hipDeviceAttributeMultiprocessorCount, dev) != hipSuccess) { grid = -1; return; }
        if (hipFuncSetAttribute((const void*)enc_fwd, hipFuncAttributeMaxDynamicSharedMemorySize, LDS_BYTES) != hipSuccess) { fprintf(stderr, "kernel_launch: hipFuncSetAttribute failed\n"); grid = -1; return; }
        int per_cu = 0;
        if (hipOccupancyMaxActiveBlocksPerMultiprocessor(&per_cu, (const void*)enc_fwd, NWAVES * 64, LDS_BYTES) != hipSuccess || per_cu < 1) fprintf(stderr, "kernel_launch: occupancy query reports %d\n", per_cu);
        (void)hipGetLastError();
        grid = cus;
    }
    if (grid < 0) return;
    if (hipMemsetAsync((char*)d_ws + WS_CTL, 0, CTL_ZERO_BYTES, stream) != hipSuccess) return;
    Args a{};
    for (int i = 0; i < 17; ++i) a.in[i] = (const float*)d_in[i];
    a.out = (float*)d_out; a.ws = (unsigned char*)d_ws;
#if MK_ONE_LAUNCH
    a.ph_lo = 0; a.ph_hi = NPHASES;
    hipLaunchKernelGGL(enc_fwd, dim3(grid), dim3(NWAVES * 64), LDS_BYTES, stream, a);
#else
    for (int p = 0; p < NPHASES; ++p) { a.ph_lo = p; a.ph_hi = p + 1; hipLaunchKernelGGL(enc_fwd, dim3(grid), dim3(NWAVES * 64), LDS_BYTES, stream, a); }
#endif
}
```

```cpp
#include <hip/hip_runtime.h>
#include <cstdio>
#include <cstdint>
namespace pg8 {
#define PG8_LAS __attribute__((address_space(3)))
typedef unsigned short bf16_t;
typedef short bf16x8 __attribute__((ext_vector_type(8)));
typedef float f32x4 __attribute__((ext_vector_type(4)));
typedef unsigned u32x4 __attribute__((ext_vector_type(4)));
typedef int v4i_t __attribute__((ext_vector_type(4)));
typedef int v8i_t __attribute__((ext_vector_type(8)));
constexpr int BM = 256, BK = 64, HALF = 128, HTB = HALF * BK * 2  , STAGE_BYTES = 8 * HTB, NXCD = 8, WGM = 8;

__host__ __device__ __forceinline__ int lds_byte(int r, int c) { const int st = (r >> 4) * 2 + (c >> 5), rr = r & 15, cc = c & 31, ob = rr * 64 + cc * 2; return st * 1024 + (ob ^ (((ob >> 9) & 1) << 5)); }
__host__ __device__ __forceinline__ void stage_rc(int b, int& R, int& C) { const int st = b / 1024, sb = b % 1024, swz = sb ^ (((sb >> 9) & 1) << 5); R = (st >> 1) * 16 + swz / 64; C = (st & 1) * 32 + (swz % 64) / 2; }
__host__ __device__ __forceinline__ int perm32(int rho) { const int n = rho >> 4, i = rho & 15; return 8 * (i >> 2) + 4 * n + (i & 3); }

struct Unit { int pm, pn; };
struct Gemm { const bf16_t* A; const bf16_t* Bt; int M, N, K; int sw = 0x79797979, sa = 0x7f7f7f7f; };

struct StaticOrder {
    int nM, nN, nwg, G, c;
    __host__ __device__ void init(int M, int N, int G_, int c_) { nM = M / BM; nN = N / BM; nwg = nM * nN; G = G_; c = c_; }
    __host__ __device__ bool next(int i, Unit& u) const {
        const long L = (long)i * G + c; if (L >= nwg) return false;
        int wgid = (int)L; { const int q = nwg / NXCD, r = nwg % NXCD, xcd = wgid % NXCD, off = wgid / NXCD; wgid = (xcd < r ? xcd * (q + 1) : r * (q + 1) + (xcd - r) * q) + off; }
        const int nig = WGM * nN, gid = wgid / nig, fm = gid * WGM, gsz = (nM - fm) < WGM ? (nM - fm) : WGM;
        u.pm = fm + ((wgid % nig) % gsz); u.pn = (wgid % nig) / gsz; return true;
    }
    __device__ __forceinline__ void a_ready(const Unit&) const {}
    __device__ __forceinline__ void done(const Unit&) const {}
    static constexpr bool BGATHER = false;
    __device__ __forceinline__ size_t b_off(int) const { return 0; }
    int brow_bytes = 0;
};
struct DftOrder : StaticOrder {
    static constexpr bool BGATHER = true;
    int tsh; size_t gjump;
    __device__ __forceinline__ size_t b_off(int pn) const { return (size_t)pn * 1024 + (size_t)(pn >> tsh) * gjump; }
};

typedef float cvt_f32x2 __attribute__((ext_vector_type(2))); typedef __bf16 cvt_bf16x2 __attribute__((ext_vector_type(2)));
__device__ __forceinline__ unsigned cvt_pk_bf16(float lo, float hi) { cvt_f32x2 v = {lo, hi}; cvt_bf16x2 b = __builtin_convertvector(v, cvt_bf16x2); return __builtin_bit_cast(unsigned, b); }
typedef unsigned u32x2 __attribute__((ext_vector_type(2)));
typedef float f32x2 __attribute__((ext_vector_type(2)));
__device__ __forceinline__ float bf_lo(unsigned w) { return __uint_as_float(w << 16); }
__device__ __forceinline__ float bf_hi(unsigned w) { return __uint_as_float(w & 0xffff0000u); }
__device__ __forceinline__ float sigm(float x) { return __builtin_amdgcn_rcpf(1.0f + __expf(-x)); }

struct EpiBf16S {
    static constexpr bool PERM = true, AFTER_DRAIN = false;
    bf16_t* O; int ldc; float scale;
    __device__ __forceinline__ void operator()(const f32x4 (&acc)[2][2][4][2], const Unit& u, int wr, int wc, int fr, int fq) const {
        const int row0 = u.pm * BM + wr * 64 + fr, col0 = u.pn * BM + wc * 32 + 8 * fq;
#pragma unroll
        for (int ai = 0; ai < 2; ++ai)
#pragma unroll
            for (int m = 0; m < 4; ++m) { bf16_t* rowp = O + (size_t)(row0 + ai * HALF + m * 16) * ldc + col0;
#pragma unroll
                for (int bj = 0; bj < 2; ++bj) { const f32x4 v0 = acc[ai][bj][m][0] * scale, v1 = acc[ai][bj][m][1] * scale;
                    u32x4 w; w.x = cvt_pk_bf16(v0[0], v0[1]); w.y = cvt_pk_bf16(v0[2], v0[3]); w.z = cvt_pk_bf16(v1[0], v1[1]); w.w = cvt_pk_bf16(v1[2], v1[3]);
                    *(u32x4*)(rowp + bj * HALF) = w; } }
    }
};
struct EpiFour {
    static constexpr bool PERM = true, AFTER_DRAIN = false;
    bf16_t* FO; int seq_off, nkb; float scale;
    __device__ __forceinline__ void operator()(const f32x4 (&acc)[2][2][4][2], const Unit& u, int wr, int wc, int fr, int fq) const {
        const int row0 = u.pm * BM + wr * 64 + fr, kb0 = wc * 32 + 8 * fq;
        if (kb0 >= nkb) return;
#pragma unroll
        for (int ai = 0; ai < 2; ++ai)
#pragma unroll
            for (int m = 0; m < 4; ++m) { const int row = row0 + ai * HALF + m * 16, cp = row & 255, gk = row >> 8, ka = gk & 127, g = gk >> 7;
                bf16_t* p = FO + (size_t)(seq_off + ka + 128 * kb0) * 1024 + g * 256 + cp;
#pragma unroll
                for (int n = 0; n < 2; ++n)
#pragma unroll
                    for (int j = 0; j < 4; ++j) { const unsigned w = cvt_pk_bf16(acc[ai][0][m][n][j] * scale, 0.f); p[(size_t)(128 * (4 * n + j)) * 1024] = (bf16_t)(w & 0xffffu); } }
    }
};
struct EpiTwT {
    static constexpr bool PERM = true, AFTER_DRAIN = false;
    bf16_t* A2; float scale; const float* tw;
    __device__ __forceinline__ void operator()(const f32x4 (&acc)[2][2][4][2], const Unit& u, int wr, int wc, int fr, int fq) const {
        const bool smp = u.pn >= 512; const int nsh = smp ? 6 : 7, tsh = smp ? 1 : 0  , Sm1 = smp ? 8191 : 16383; const int roff = smp ? 131072 : 0;
#pragma unroll
        for (int m = 0; m < 4; ++m) { const int ka = wr * 64 + m * 16 + fr;
            const f32x2 st_ = *(const f32x2*)(tw + 2 * (ka << tsh)); const float scs = st_[0], ssn = st_[1];
#pragma unroll
            for (int bj = 0; bj < 2; ++bj) { const int rho = u.pn * BM + bj * HALF + wc * 32 + 8 * fq - roff, slo = rho & ((1 << nsh) - 1), cg = rho >> nsh, g = cg & 3, cp = cg >> 2;
                const f32x2 t0_ = *(const f32x2*)(tw + 2 * (((ka * slo) & Sm1) << tsh));
                bf16_t* p = A2 + ((size_t)roff + (size_t)((g * 128 + ka) * 256 + cp)) * 256 + slo;
#pragma unroll
                for (int ri = 0; ri < 2; ++ri) { float cs = t0_[0], sn = t0_[1]; float o_[8];
#pragma unroll
                    for (int n = 0; n < 2; ++n)
#pragma unroll
                        for (int j = 0; j < 4; ++j) { const float yr = acc[0][bj][m][n][j] * scale, yi = acc[1][bj][m][n][j] * scale; o_[4 * n + j] = ri ? yi * cs - yr * sn : yr * cs + yi * sn;
                            const float c2 = cs * scs - sn * ssn; sn = sn * scs + cs * ssn; cs = c2; }
                    u32x4 w; w.x = cvt_pk_bf16(o_[0], o_[1]); w.y = cvt_pk_bf16(o_[2], o_[3]); w.z = cvt_pk_bf16(o_[4], o_[5]); w.w = cvt_pk_bf16(o_[6], o_[7]); *(u32x4*)(p + 128 * ri) = w; }
                if (smp) { const u32x4 z = {0u, 0u, 0u, 0u}; *(u32x4*)(p + 64) = z; *(u32x4*)(p + 192) = z; } }
            asm volatile("" ::: "memory"); }
    }
};
struct EpiA1 {
    static constexpr bool PERM = true, AFTER_DRAIN = false;
    bf16_t* A1; int tsh, nsh; float scale;
    __device__ __forceinline__ void operator()(const f32x4 (&acc)[2][2][4][2], const Unit& u, int wr, int wc, int fr, int fq) const {
        const int g = u.pn >> tsh, t = u.pn & ((1 << tsh) - 1), sh0 = wc * 32 + 8 * fq, ri = u.pm;
#pragma unroll
        for (int ai = 0; ai < 2; ++ai)
#pragma unroll
            for (int m = 0; m < 4; ++m) { const int cp = ai * HALF + wr * 64 + m * 16 + fr;
#pragma unroll
                for (int bj = 0; bj < 2; ++bj) { const int slo = 2 * t + bj; const f32x4 v0 = acc[ai][bj][m][0] * scale, v1 = acc[ai][bj][m][1] * scale;
                    u32x4 w; w.x = cvt_pk_bf16(v0[0], v0[1]); w.y = cvt_pk_bf16(v0[2], v0[3]); w.z = cvt_pk_bf16(v1[0], v1[1]); w.w = cvt_pk_bf16(v1[2], v1[3]);
                    *(u32x4*)(A1 + (size_t)((((cp * 4 + g) << nsh) + slo)) * 256 + ri * 128 + sh0) = w; } }
    }
};
__device__ __forceinline__ void pair_store_bf16(bf16_t* rowp_even  , size_t row_stride, const u32x4& x0, const u32x4& x1, bool odd) {
    u32x4 s_, r_, d1, d2;
#pragma unroll
    for (int k = 0; k < 4; ++k) { s_[k] = odd ? x0[k] : x1[k]; r_[k] = (unsigned)__builtin_amdgcn_mov_dpp((int)s_[k], 0xB1, 0xF, 0xF, true); d1[k] = odd ? r_[k] : x0[k]; d2[k] = odd ? x1[k] : r_[k]; }
    *(u32x4*)rowp_even = d1; *(u32x4*)(rowp_even + row_stride) = d2;
}
struct EpiQKVF {
    static constexpr bool PERM = true, AFTER_DRAIN = false;
    bf16_t *Q, *Kb, *V, *F; const float* rope; int pn_off;
    __device__ __forceinline__ void operator()(const f32x4 (&acc)[2][2][4][2], const Unit& u, int wr, int wc, int fr, int fq) const {
        const int row0 = u.pm * BM + wr * 64 + fr; const int pn = u.pn + pn_off;
        if (pn < 24) {
            bf16_t* base = pn < 12 ? Q : Kb; const int hp = pn < 12 ? pn : pn - 12;
            const int seq_off = u.pm >= 64 ? 16384 : 0;
            const float qs = pn < 12 ? 0.08838834764831845f * 1.4426950408889634f : 1.0f;
            const int head = 2 * hp + (wc >> 1), d0 = 32 * (wc & 1) + 8 * fq;
#pragma unroll
            for (int ai = 0; ai < 2; ++ai)
#pragma unroll
                for (int m = 0; m < 4; ++m) { const int row = row0 + ai * HALF + m * 16; const int pos = row - seq_off;
                    const u32x4* rp = (const u32x4*)((const unsigned*)rope + ((size_t)pos * 64 + d0));
                    u32x4 wa, wb;
#pragma unroll
                    for (int bj = 0; bj < 2; ++bj) { const u32x4 rr = rp[bj];
                        const float cs[4] = {bf_lo(rr[0]), bf_lo(rr[1]), bf_lo(rr[2]), bf_lo(rr[3])}, sn[4] = {bf_hi(rr[0]), bf_hi(rr[1]), bf_hi(rr[2]), bf_hi(rr[3])};
                        const f32x4 t1 = acc[ai][bj][m][0], t2 = acc[ai][bj][m][1]; float o1[4], o2[4];
#pragma unroll
                        for (int j = 0; j < 4; ++j) { o1[j] = (t1[j] * cs[j] - t2[j] * sn[j]) * qs; o2[j] = (t2[j] * cs[j] + t1[j] * sn[j]) * qs; }
                        wa[2 * bj] = cvt_pk_bf16(o1[0], o1[1]); wa[2 * bj + 1] = cvt_pk_bf16(o1[2], o1[3]); wb[2 * bj] = cvt_pk_bf16(o2[0], o2[1]); wb[2 * bj + 1] = cvt_pk_bf16(o2[2], o2[3]); }
                    const bool odd = fr & 1;
                    pair_store_bf16(base + (size_t)(row - (odd ? 1 : 0)) * 3072 + head * 128 + 64 * (wc & 1) + 8 * fq + (odd ? 32 : 0), 3072, wa, wb, odd); }
        } else {
            if (pn < 36) {
                unsigned char* vb = (unsigned char*)V + (size_t)((pn - 24) * 256 + wc * 64 + 16 * fq);
#pragma unroll
                for (int ai = 0; ai < 2; ++ai)
#pragma unroll
                    for (int m = 0; m < 4; ++m) { unsigned char* rowp = vb + (size_t)(row0 + ai * HALF + m * 16) * 3072; u32x4 w;
#pragma unroll
                        for (int bj = 0; bj < 2; ++bj) { const f32x4 v0 = acc[ai][bj][m][0] * 16.f, v1 = acc[ai][bj][m][1] * 16.f; int t = 0;
                            t = __builtin_amdgcn_cvt_pk_fp8_f32(v0[0], v0[1], t, false); t = __builtin_amdgcn_cvt_pk_fp8_f32(v0[2], v0[3], t, true); w[2 * bj] = (unsigned)t; t = 0;
                            t = __builtin_amdgcn_cvt_pk_fp8_f32(v1[0], v1[1], t, false); t = __builtin_amdgcn_cvt_pk_fp8_f32(v1[2], v1[3], t, true); w[2 * bj + 1] = (unsigned)t; }
                        *(u32x4*)rowp = w; }
                return; }
            bf16_t* base = F + (size_t)(pn - 36) * 24576 * 256; const bool odd = fr & 1;
#pragma unroll
            for (int ai = 0; ai < 2; ++ai)
#pragma unroll
                for (int m = 0; m < 4; ++m) { u32x4 w[2];
#pragma unroll
                    for (int bj = 0; bj < 2; ++bj) { const f32x4 v0 = acc[ai][bj][m][0], v1 = acc[ai][bj][m][1];
                        w[bj].x = cvt_pk_bf16(v0[0], v0[1]); w[bj].y = cvt_pk_bf16(v0[2], v0[3]); w[bj].z = cvt_pk_bf16(v1[0], v1[1]); w[bj].w = cvt_pk_bf16(v1[2], v1[3]); }
                    pair_store_bf16(base + (size_t)(row0 + ai * HALF + m * 16 - (odd ? 1 : 0)) * 256 + wc * 64 + 16 * fq + (odd ? 8 : 0), 256, w[0], w[1], odd); }
        }
    }
};
__device__ __forceinline__ size_t pr_off(size_t row, int col, int width) { return (row >> 1) * (size_t)(2 * width) + (size_t)((col & ~63) << 1) + ((row & 1) << 6) + (col & 63); }
struct EpiGates {
    static constexpr bool PERM = true, AFTER_DRAIN = false;
    unsigned char* G;
    static __device__ __forceinline__ unsigned q8x4(const f32x4 v) {
        const f32x4 e = {__builtin_amdgcn_exp2f(-v[0]), __builtin_amdgcn_exp2f(-v[1]), __builtin_amdgcn_exp2f(-v[2]), __builtin_amdgcn_exp2f(-v[3])}; const f32x4 den = e + 1.0f;
        const f32x4 r = {__builtin_amdgcn_rcpf(den[0]), __builtin_amdgcn_rcpf(den[1]), __builtin_amdgcn_rcpf(den[2]), __builtin_amdgcn_rcpf(den[3])}; const f32x4 q = r * 256.f + 0.5f;
        return (unsigned)fminf(q[0], 255.5f) | ((unsigned)fminf(q[1], 255.5f) << 8) | ((unsigned)fminf(q[2], 255.5f) << 16) | ((unsigned)fminf(q[3], 255.5f) << 24); }
    __device__ __forceinline__ void operator()(const f32x4 (&acc)[2][2][4][2], const Unit& u, int wr, int wc, int fr, int fq) const {
        const int row0 = u.pm * BM + wr * 64 + fr, col0 = u.pn * BM + wc * 64 + 16 * fq;
#pragma unroll
        for (int ai = 0; ai < 2; ++ai)
#pragma unroll
            for (int m = 0; m < 4; ++m) { unsigned char* rowp = G + pr_off((size_t)(row0 + ai * HALF + m * 16), col0, 8192); u32x4 w;
#pragma unroll
                for (int bj = 0; bj < 2; ++bj) { const f32x4 v0 = acc[ai][bj][m][0], v1 = acc[ai][bj][m][1];
                    w[2 * bj] = q8x4(v0); w[2 * bj + 1] = q8x4(v1); }
                *(u32x4*)rowp = w; }
    }
};
template <int MODE> struct EpiBranch {
    static constexpr bool PERM = true, AFTER_DRAIN = false;
    const unsigned char* G; bf16_t* Mg; unsigned char* Ma;
    static __device__ __forceinline__ float ub(unsigned w, int k) { return (float)((w >> (8 * k)) & 255u); }
    __device__ __forceinline__ void operator()(const f32x4 (&acc)[2][2][4][2], const Unit& u, int wr, int wc, int fr, int fq) const {
        const int row0 = u.pm * BM + wr * 64 + fr;
        if constexpr (MODE == 0) {
            const int col0 = u.pn * BM + wc * 64 + 16 * fq;
#pragma unroll
            for (int ai = 0; ai < 2; ++ai)
#pragma unroll
                for (int m = 0; m < 4; ++m) { const size_t row = (size_t)(row0 + ai * HALF + m * 16);
                    const u32x4 g = *(const u32x4*)(G + pr_off(row, col0, 8192)); u32x4 w;
#pragma unroll
                    for (int bj = 0; bj < 2; ++bj) { const f32x4 v0 = acc[ai][bj][m][0], v1 = acc[ai][bj][m][1]; const unsigned g0 = g[2 * bj], g1 = g[2 * bj + 1]; int t = 0;
                        t = __builtin_amdgcn_cvt_pk_fp8_f32(64.f * ub(g0, 0) * v0[0], 64.f * ub(g0, 1) * v0[1], t, false); t = __builtin_amdgcn_cvt_pk_fp8_f32(64.f * ub(g0, 2) * v0[2], 64.f * ub(g0, 3) * v0[3], t, true); w[2 * bj] = (unsigned)t; t = 0;
                        t = __builtin_amdgcn_cvt_pk_fp8_f32(64.f * ub(g1, 0) * v1[0], 64.f * ub(g1, 1) * v1[1], t, false); t = __builtin_amdgcn_cvt_pk_fp8_f32(64.f * ub(g1, 2) * v1[2], 64.f * ub(g1, 3) * v1[3], t, true); w[2 * bj + 1] = (unsigned)t; }
                    *(u32x4*)(Ma + pr_off(row, col0, 4096)) = w; }
        } else {
            const int col0 = u.pn * BM + wc * 64 + 16 * fq; const bool odd = fr & 1;
#pragma unroll
            for (int ai = 0; ai < 2; ++ai)
#pragma unroll
                for (int m = 0; m < 4; ++m) { const size_t row = (size_t)(row0 + ai * HALF + m * 16);
                    const u32x4 g4 = *(const u32x4*)(G + pr_off(row, 4096 + col0, 8192)), p4 = *(const u32x4*)(Ma + pr_off(row, col0, 4096)); u32x4 w[2];
#pragma unroll
                    for (int bj = 0; bj < 2; ++bj) { const f32x4 v0 = acc[ai][bj][m][0], v1 = acc[ai][bj][m][1];
                        const unsigned gx = g4[2 * bj], gy = g4[2 * bj + 1], px = p4[2 * bj], py = p4[2 * bj + 1];
                        float o[8] = {ub(gx, 0) * v0[0], ub(gx, 1) * v0[1], ub(gx, 2) * v0[2], ub(gx, 3) * v0[3], ub(gy, 0) * v1[0], ub(gy, 1) * v1[1], ub(gy, 2) * v1[2], ub(gy, 3) * v1[3]};
                        const cvt_f32x2 p0 = __builtin_amdgcn_cvt_pk_f32_fp8((int)px, false), p1 = __builtin_amdgcn_cvt_pk_f32_fp8((int)px, true), p2 = __builtin_amdgcn_cvt_pk_f32_fp8((int)py, false), p3 = __builtin_amdgcn_cvt_pk_f32_fp8((int)py, true);
                        o[0] += 0.015625f * p0[0]; o[1] += 0.015625f * p0[1]; o[2] += 0.015625f * p1[0]; o[3] += 0.015625f * p1[1]; o[4] += 0.015625f * p2[0]; o[5] += 0.015625f * p2[1]; o[6] += 0.015625f * p3[0]; o[7] += 0.015625f * p3[1];
                        w[bj].x = cvt_pk_bf16(o[0], o[1]); w[bj].y = cvt_pk_bf16(o[2], o[3]); w[bj].z = cvt_pk_bf16(o[4], o[5]); w[bj].w = cvt_pk_bf16(o[6], o[7]); }
                    pair_store_bf16(Mg + (row - (odd ? 1 : 0)) * 4096 + col0 + (odd ? 8 : 0), 4096, w[0], w[1], odd); }
        }
    }
};
struct EpiResid {
    static constexpr bool PERM = false, AFTER_DRAIN = false;
    const float* base0; const float* base1; float* out; const float* gate0; const float* gate1; float alpha;
    __device__ __forceinline__ void operator()(const f32x4 (&acc)[2][2][4][2], const Unit& u, int wr, int wc, int fr, int fq) const {
        const int row0 = u.pm * BM + wr * 64 + fr, col0 = u.pn * BM + wc * 32 + 4 * fq;
        const bool smp = u.pm >= 64; const float* gate = smp ? gate1 : gate0; const float* bs = smp ? base1 - (size_t)16384 * 4096 : base0;
        f32x4 gv[2][2];
#pragma unroll
        for (int bj = 0; bj < 2; ++bj)
#pragma unroll
            for (int n = 0; n < 2; ++n) gv[bj][n] = *(const f32x4*)(gate + col0 + bj * HALF + n * 16);
#pragma unroll
        for (int ai = 0; ai < 2; ++ai)
#pragma unroll
            for (int m = 0; m < 4; ++m) { const size_t off = (size_t)(row0 + ai * HALF + m * 16) * 4096 + col0;
#pragma unroll
                for (int bj = 0; bj < 2; ++bj)
#pragma unroll
                    for (int n = 0; n < 2; ++n) { const f32x4 b = *(const f32x4*)(bs + off + bj * HALF + n * 16);
                        *(f32x4*)(out + off + bj * HALF + n * 16) = b * alpha + gv[bj][n] * acc[ai][bj][m][n]; } }
    }
};
struct EpiContrib {
    static constexpr bool PERM = true, AFTER_DRAIN = false;
    bf16_t* C; const float* gate0; const float* gate1;
    __device__ __forceinline__ void operator()(const f32x4 (&acc)[2][2][4][2], const Unit& u, int wr, int wc, int fr, int fq) const {
        const int row0 = u.pm * BM + wr * 64 + fr, col0 = u.pn * BM + wc * 64 + 16 * fq;
        const float* gate = u.pm >= 64 ? gate1 : gate0; const bool odd = fr & 1;
        f32x4 gv[2][2];
#pragma unroll
        for (int bj = 0; bj < 2; ++bj)
#pragma unroll
            for (int n = 0; n < 2; ++n) gv[bj][n] = *(const f32x4*)(gate + col0 + bj * 8 + 4 * n);
#pragma unroll
        for (int ai = 0; ai < 2; ++ai)
#pragma unroll
            for (int m = 0; m < 4; ++m) { u32x4 w[2];
#pragma unroll
                for (int bj = 0; bj < 2; ++bj) { const f32x4 v0 = acc[ai][bj][m][0] * gv[bj][0], v1 = acc[ai][bj][m][1] * gv[bj][1];
                    w[bj].x = cvt_pk_bf16(v0[0], v0[1]); w[bj].y = cvt_pk_bf16(v0[2], v0[3]); w[bj].z = cvt_pk_bf16(v1[0], v1[1]); w[bj].w = cvt_pk_bf16(v1[2], v1[3]); }
                pair_store_bf16(C + (size_t)(row0 + ai * HALF + m * 16 - (odd ? 1 : 0)) * 4096 + col0 + (odd ? 8 : 0), 4096, w[0], w[1], odd); }
    }
};
constexpr float LOG2E_16 = 1.4426950408889634f / 16.0f;
struct EpiGU {
    static constexpr bool PERM = true, AFTER_DRAIN = false;
    unsigned char* Hd;
    __device__ __forceinline__ void operator()(const f32x4 (&acc)[2][2][4][2], const Unit& u, int wr, int wc, int fr, int fq) const {
        const int row0 = u.pm * BM + wr * 64 + fr, col0 = u.pn * 128 + wc * 32 + 8 * fq;
#pragma unroll
        for (int ai = 0; ai < 2; ++ai)
#pragma unroll
            for (int m = 0; m < 4; ++m) { unsigned char* rowp = Hd + (size_t)(row0 + ai * HALF + m * 16) * 11008 + col0; u32x2 w2;
#pragma unroll
                for (int bj = 0; bj < 2; ++bj) { const f32x4 g = acc[ai][bj][m][0], up = acc[ai][bj][m][1];
                    const f32x4 e = {__builtin_amdgcn_exp2f(-g[0]), __builtin_amdgcn_exp2f(-g[1]), __builtin_amdgcn_exp2f(-g[2]), __builtin_amdgcn_exp2f(-g[3])};
                    const f32x4 den = e * LOG2E_16 + LOG2E_16;
                    const f32x4 rc = {__builtin_amdgcn_rcpf(den[0]), __builtin_amdgcn_rcpf(den[1]), __builtin_amdgcn_rcpf(den[2]), __builtin_amdgcn_rcpf(den[3])};
                    const f32x4 o = (g * up) * rc;
                    int w = 0; w = __builtin_amdgcn_cvt_pk_fp8_f32(o[0], o[1], w, false); w = __builtin_amdgcn_cvt_pk_fp8_f32(o[2], o[3], w, true);
                    w2[bj] = (unsigned)w; }
                *(u32x2*)rowp = w2; }
    }
};
template <class Epi, class Sched, bool ALIGN_EPI = false, bool SP2 = false, bool FP8 = false>
__device__ __forceinline__ void gemm_phase(PG8_LAS unsigned char* lds, const Gemm g, const Sched& S, const Epi& E, int tid_in) {
    int tid_ = tid_in; asm volatile("" : "+v"(tid_));
    const int tid = tid_, wid = __builtin_amdgcn_readfirstlane(tid >> 6), lane = tid & 63, wr = wid >> 2, wc = wid & 3, fr = lane & 15, fq = lane >> 4;
    const int K = g.K, RB = FP8 ? K : 2 * K  , nt = RB / (BK * 2);
    unsigned voffA[2], voffB[2];
#pragma unroll
    for (int i = 0; i < 2; ++i) { int R, C; stage_rc(tid * 16 + i * 8192, R, C); const int Rb = Epi::PERM ? ((R & ~31) + perm32(R & 31)) : R;
        voffA[i] = (unsigned)(R * RB + C * 2); voffB[i] = (unsigned)(Rb * (Sched::BGATHER ? S.brow_bytes : RB) + C * 2); }
    const size_t kstep = (size_t)(BK * 2);
    const size_t hstep = (size_t)HALF * RB;
    const size_t tstep = 2 * hstep;
    const size_t hstepB = Sched::BGATHER ? (size_t)512 : hstep;
    const unsigned ldsw = (unsigned)wid * 1024u;
    const int aoff = lds_byte(wr * 64 + fr, fq * 8), boff = lds_byte(wc * 32 + fr, fq * 8);
#define PG8_SA(b, h) (((b) * 2 + (h)) * HTB)
#define PG8_SB(b, h) ((4 + (b) * 2 + (h)) * HTB)
#define PG8_STAGE(bufoff, gbase, voff) do { _Pragma("unroll") for (int _i = 0; _i < 2; ++_i) \
        __builtin_amdgcn_global_load_lds((const unsigned*)((const char*)(gbase) + (voff)[_i]), (PG8_LAS unsigned*)(lds + (bufoff) + ldsw + _i * 8192), 16, 0, 0); } while (0)
#define PG8_LDA(dst, b, h) do { if constexpr (FP8) { _Pragma("unroll") for (int m = 0; m < 4; ++m) { const v4i_t lo_ = *(const PG8_LAS v4i_t*)(lds + PG8_SA(b, h) + aoff + m * 2048), hi_ = *(const PG8_LAS v4i_t*)(lds + PG8_SA(b, h) + aoff + m * 2048 + 1024); dst##8[m] = __builtin_shufflevector(lo_, hi_, 0, 1, 2, 3, 4, 5, 6, 7); } } \
      else { _Pragma("unroll") for (int m = 0; m < 4; ++m) _Pragma("unroll") for (int k = 0; k < 2; ++k) dst[m][k] = *(const PG8_LAS bf16x8*)(lds + PG8_SA(b, h) + aoff + m * 2048 + k * 1024); } } while (0)
#define PG8_LDB(dst, b, h) do { if constexpr (FP8) { _Pragma("unroll") for (int n = 0; n < 2; ++n) { const v4i_t lo_ = *(const PG8_LAS v4i_t*)(lds + PG8_SB(b, h) + boff + n * 2048), hi_ = *(const PG8_LAS v4i_t*)(lds + PG8_SB(b, h) + boff + n * 2048 + 1024); dst##8[n] = __builtin_shufflevector(lo_, hi_, 0, 1, 2, 3, 4, 5, 6, 7); } } \
      else { _Pragma("unroll") for (int n = 0; n < 2; ++n) _Pragma("unroll") for (int k = 0; k < 2; ++k) dst[n][k] = *(const PG8_LAS bf16x8*)(lds + PG8_SB(b, h) + boff + n * 2048 + k * 1024); } } while (0)
#define PG8_MMA(ai, bj, At, Bt) do { __builtin_amdgcn_s_setprio(1); if constexpr (FP8) { _Pragma("unroll") for (int m = 0; m < 4; ++m) _Pragma("unroll") for (int n = 0; n < 2; ++n) \
        asm volatile("v_mfma_scale_f32_16x16x128_f8f6f4 %0, %1, %2, %0, %3, %4 op_sel_hi:[0,0,0]" : "+v"(acc[ai][bj][m][n]) : "v"(Bt##8[n]), "v"(At##8[m]), "v"(sc_w), "v"(sc_a)); } \
      else { _Pragma("unroll") for (int m = 0; m < 4; ++m) _Pragma("unroll") for (int n = 0; n < 2; ++n) _Pragma("unroll") for (int k = 0; k < 2; ++k) \
        acc[ai][bj][m][n] = __builtin_amdgcn_mfma_f32_16x16x32_bf16(Bt[n][k], At[m][k], acc[ai][bj][m][n], 0, 0, 0); } __builtin_amdgcn_s_setprio(0); } while (0)
#define PG8_WAIT_V(n) asm volatile("s_waitcnt vmcnt(" #n ")" ::: "memory")
#define PG8_WAIT_L(n) asm volatile("s_waitcnt lgkmcnt(" #n ")" ::: "memory")
#define PG8_BAR __builtin_amdgcn_s_barrier()
#define PG8_SCHED __builtin_amdgcn_sched_barrier(0)
    Unit cur, nxt; int ui = 0;
    if (!S.next(0, cur)) return;
    f32x4 acc[2][2][4][2];
#pragma unroll
    for (int a = 0; a < 2; ++a)
#pragma unroll
        for (int b = 0; b < 2; ++b)
#pragma unroll
            for (int m = 0; m < 4; ++m)
#pragma unroll
                for (int n = 0; n < 2; ++n) acc[a][b][m][n] = (f32x4){0.f, 0.f, 0.f, 0.f};
    int sc_w = g.sw, sc_a = g.sa; asm volatile("" : "+v"(sc_w), "+v"(sc_a));
    bf16x8 At[4][2], B0[2][2], B1[2][2]; v8i_t At8[4], B08[2], B18[2];
    const char* cA = (const char*)g.A + (size_t)cur.pm * tstep; const char* cB = (const char*)g.Bt + (Sched::BGATHER ? S.b_off(cur.pn) : (size_t)cur.pn * tstep);
    S.a_ready(cur);
    if constexpr (SP2) {
        PG8_STAGE(PG8_SB(0, 0), cB, voffB); PG8_STAGE(PG8_SB(0, 1), cB + hstepB, voffB); PG8_STAGE(PG8_SA(0, 0), cA, voffA); PG8_STAGE(PG8_SA(0, 1), cA + hstep, voffA);
        if (wr == 1) PG8_BAR;
        PG8_WAIT_V(2); PG8_BAR;
        PG8_STAGE(PG8_SB(1, 0), cB + kstep, voffB); PG8_STAGE(PG8_SA(1, 0), cA + kstep, voffA); PG8_STAGE(PG8_SB(1, 1), cB + hstepB + kstep, voffB);
        PG8_WAIT_V(6); PG8_BAR;
    } else {
        PG8_STAGE(PG8_SB(0, 0), cB, voffB); PG8_STAGE(PG8_SA(0, 0), cA, voffA); PG8_STAGE(PG8_SB(0, 1), cB + hstepB, voffB); PG8_STAGE(PG8_SA(0, 1), cA + hstep, voffA);
        if (wr == 1) PG8_BAR;
        PG8_WAIT_V(4); PG8_BAR;
        PG8_STAGE(PG8_SB(1, 0), cB + kstep, voffB); PG8_STAGE(PG8_SA(1, 0), cA + kstep, voffA); PG8_STAGE(PG8_SB(1, 1), cB + hstepB + kstep, voffB);
        PG8_WAIT_V(6); PG8_BAR;
    }
    for (;;) {
        const bool has_next = S.next(ui + 1, nxt);
        const char* nA = has_next ? (const char*)g.A + (size_t)nxt.pm * tstep : cA; const char* nB = has_next ? (const char*)g.Bt + (Sched::BGATHER ? S.b_off(nxt.pn) : (size_t)nxt.pn * tstep) : cB;
        for (int t = 0; t < nt; t += 2) {
            const bool last = (t == nt - 2);
            const char* a1 = cA + (size_t)(t + 1) * kstep;
            const char* a2 = last ? nA : cA + (size_t)(t + 2) * kstep; const char* b2 = last ? nB : cB + (size_t)(t + 2) * kstep;
            const char* a3 = a2 + kstep; const char* b3 = b2 + kstep;
            if (last && has_next) S.a_ready(nxt);
            if constexpr (SP2) {
            PG8_LDB(B0, 0, 0); PG8_LDB(B1, 0, 1); PG8_SCHED; PG8_LDA(At, 0, 0); PG8_STAGE(PG8_SA(1, 1), a1 + hstep, voffA);
            PG8_WAIT_V(8); PG8_WAIT_L(0); PG8_BAR; PG8_MMA(0, 0, At, B0); PG8_MMA(0, 1, At, B1); PG8_BAR; PG8_SCHED;
            PG8_LDA(At, 0, 1); PG8_STAGE(PG8_SB(0, 0), b2, voffB); PG8_STAGE(PG8_SB(0, 1), b2 + hstepB, voffB); PG8_STAGE(PG8_SA(0, 0), a2, voffA);
            PG8_WAIT_V(8); PG8_WAIT_L(0); PG8_BAR; PG8_MMA(1, 0, At, B0); PG8_MMA(1, 1, At, B1); PG8_BAR; PG8_SCHED;
            PG8_LDB(B0, 1, 0); PG8_LDB(B1, 1, 1); PG8_SCHED; PG8_LDA(At, 1, 0); PG8_STAGE(PG8_SA(0, 1), a2 + hstep, voffA);
            PG8_WAIT_V(8); PG8_WAIT_L(0); PG8_BAR; PG8_MMA(0, 0, At, B0); PG8_MMA(0, 1, At, B1); PG8_BAR; PG8_SCHED;
            PG8_LDA(At, 1, 1); PG8_STAGE(PG8_SB(1, 0), b3, voffB); PG8_STAGE(PG8_SB(1, 1), b3 + hstepB, voffB); PG8_STAGE(PG8_SA(1, 0), a3, voffA);
            PG8_WAIT_V(8); PG8_WAIT_L(0); PG8_BAR; PG8_MMA(1, 0, At, B0); PG8_MMA(1, 1, At, B1); PG8_BAR; PG8_SCHED;
            } else {
            PG8_LDB(B0, 0, 0); PG8_SCHED; PG8_LDA(At, 0, 0); PG8_STAGE(PG8_SA(1, 1), a1 + hstep, voffA);
            PG8_WAIT_L(8); PG8_BAR; PG8_WAIT_L(0); PG8_MMA(0, 0, At, B0); PG8_BAR; PG8_SCHED;
            PG8_LDB(B1, 0, 1); PG8_STAGE(PG8_SB(0, 0), b2, voffB);
            PG8_BAR; PG8_WAIT_L(0); PG8_MMA(0, 1, At, B1); PG8_BAR;
            PG8_LDA(At, 0, 1); PG8_STAGE(PG8_SA(0, 0), a2, voffA);
            PG8_BAR; PG8_WAIT_L(0); PG8_MMA(1, 0, At, B0); PG8_BAR; PG8_SCHED;
            PG8_STAGE(PG8_SB(0, 1), b2 + hstepB, voffB);
            PG8_WAIT_V(6); PG8_BAR; PG8_MMA(1, 1, At, B1); PG8_BAR;
            PG8_LDB(B0, 1, 0); PG8_SCHED; PG8_LDA(At, 1, 0); PG8_STAGE(PG8_SA(0, 1), a2 + hstep, voffA);
            PG8_WAIT_L(8); PG8_BAR; PG8_WAIT_L(0); PG8_MMA(0, 0, At, B0); PG8_BAR; PG8_SCHED;
            PG8_LDB(B1, 1, 1); PG8_STAGE(PG8_SB(1, 0), b3, voffB);
            PG8_BAR; PG8_WAIT_L(0); PG8_MMA(0, 1, At, B1); PG8_BAR;
            PG8_LDA(At, 1, 1); PG8_STAGE(PG8_SA(1, 0), a3, voffA);
            PG8_BAR; PG8_WAIT_L(0); PG8_MMA(1, 0, At, B0); PG8_BAR; PG8_SCHED;
            PG8_STAGE(PG8_SB(1, 1), b3 + hstepB, voffB);
            PG8_WAIT_V(6); PG8_BAR; PG8_MMA(1, 1, At, B1); PG8_BAR;
            }
        }
        if constexpr (ALIGN_EPI) { if (wr == 0) PG8_BAR; }
        if constexpr (FP8) asm volatile("s_nop 15\n\ts_nop 15" ::: "memory");
        if constexpr (!Epi::AFTER_DRAIN) { E(acc, cur, wr, wc, fr, fq); S.done(cur); }
        if (!has_next) break;
#pragma unroll
        for (int a = 0; a < 2; ++a)
#pragma unroll
            for (int b = 0; b < 2; ++b)
#pragma unroll
                for (int m = 0; m < 4; ++m)
#pragma unroll
                    for (int n = 0; n < 2; ++n) acc[a][b][m][n] = (f32x4){0.f, 0.f, 0.f, 0.f};
        cur = nxt; cA = nA; cB = nB; ++ui;
        if constexpr (ALIGN_EPI) { if (wr == 1) PG8_BAR; }
    }
    PG8_WAIT_V(0);
    if constexpr (!ALIGN_EPI) { if (wr == 0) PG8_BAR; }
    PG8_BAR;
    if constexpr (Epi::AFTER_DRAIN) { E.fused(acc, cur, wr, wc, fr, fq, lds, wid, lane); S.done(cur); }
#undef PG8_SA
#undef PG8_SB
#undef PG8_STAGE
#undef PG8_LDA
#undef PG8_LDB
#undef PG8_MMA
#undef PG8_WAIT_V
#undef PG8_WAIT_L
#undef PG8_BAR
#undef PG8_SCHED
}
}

constexpr int S0 = 16384, S1 = 8192, M = S0 + S1, D = 4096, AW = 3072, NQKVF = 10240, NGATE = 8192, FF = 11008, NGU = 2 * FF, INW = 18432;
constexpr float LN_EPS = 1e-5f;
constexpr float ALPHA = 1.189207115002721f;
constexpr int NWAVES = 8;
#ifndef MK_ONE_LAUNCH
#define MK_ONE_LAUNCH 1
#endif
constexpr int NPHASES = 16;

constexpr size_t MiB = 1u << 20;
constexpr size_t WS_CTL = 0, CTL_ZERO_BYTES = 64 * 1024;
constexpr size_t WS_MODP = 1 * MiB;
constexpr size_t WS_MOD = 13 * MiB;
constexpr size_t WS_ROPE = 14 * MiB;
constexpr size_t WS_C256 = 22 * MiB;
constexpr size_t WS_D128 = WS_C256 + 256 * 1024;
constexpr size_t WS_D64 = WS_D128 + 128 * 1024;
constexpr size_t WS_TW = WS_D64 + 128 * 1024;
constexpr size_t WS_LSE = 24 * MiB;
constexpr size_t WS_W8 = 32 * MiB;
constexpr size_t WS_WF = 100 * MiB;
constexpr size_t WS_H8 = 1338 * MiB;
constexpr size_t WS_WAU = 176 * MiB;
constexpr size_t WS_WFU = 184 * MiB;
constexpr size_t WS_WMIX = 192 * MiB;
constexpr size_t WS_WGU = 224 * MiB;
constexpr size_t WS_WD = 396 * MiB;
constexpr size_t WS_H = 482 * MiB;
constexpr size_t WS_Q = 674 * MiB, WS_K = 818 * MiB, WS_V = 962 * MiB, WS_F = 1106 * MiB;
constexpr size_t WS_G = 674 * MiB;
constexpr size_t WS_HID = 674 * MiB;
constexpr size_t WS_C1 = 674 * MiB;
constexpr size_t WS_C2 = 962 * MiB;
constexpr size_t WS_OG = 1194 * MiB;
constexpr size_t WS_MA = 866 * MiB;
constexpr size_t WS_X1H = 1194 * MiB;
constexpr size_t WS_END = 1434 * MiB;
static_assert(WS_G + (size_t)24576 * 8192 <= WS_MA && WS_MA + (size_t)24576 * 4096 <= WS_OG, "ws map ma");
static_assert(WS_X1H + (size_t)24576 * 4096 * 2 <= WS_END, "ws map x1h");
static_assert(WS_W8 + (size_t)17408 * D <= WS_WF && WS_WF + (size_t)1024 * D * 2 <= WS_WAU && WS_WGU + (size_t)NGU * D * 2 <= WS_WD && WS_WD + (size_t)D * FF * 2 <= WS_H && WS_H + (size_t)M * D * 2 <= WS_Q, "ws map 1");
static_assert(WS_F + (size_t)4 * M * 256 * 2 <= WS_OG && WS_HID + (size_t)M * FF * 2 <= WS_OG && WS_G + (size_t)M * NGATE * 2 <= WS_F && WS_OG + (size_t)M * AW * 2 <= WS_H8 && WS_H8 + (size_t)M * D <= WS_END, "ws map 2");
constexpr size_t DO_Z = 0, DO_A1 = 96 * MiB, DO_A2 = 192 * MiB, DO_FOUR = 0, DO_ATTN = 336 * MiB;
constexpr int CW_BAR = 4096;

constexpr int RING_OFF = 0, RING_BYTES = 131072;
constexpr int LDSCTL_OFF = RING_BYTES, MISC_OFF = LDSCTL_OFF + 320;
constexpr int LDS_BYTES = 147456;

#define GAS __attribute__((address_space(1)))
#define LAS __attribute__((address_space(3)))
typedef unsigned short bf16;
typedef unsigned v4u __attribute__((ext_vector_type(4)));
typedef unsigned v2u __attribute__((ext_vector_type(2)));
typedef float f32x4 __attribute__((ext_vector_type(4)));
typedef short bf16x8 __attribute__((ext_vector_type(8)));
typedef GAS unsigned gu32;
#define RLX_AGENT __ATOMIC_RELAXED, __HIP_MEMORY_SCOPE_AGENT
#define LDS_WAIT() asm volatile("s_waitcnt lgkmcnt(0)" ::: "memory")
__device__ __forceinline__ unsigned f2bf(float f) { unsigned u = __builtin_bit_cast(unsigned, f); return (u + 0x7fffu + ((u >> 16) & 1u)) >> 16; }
__device__ __forceinline__ unsigned pk2(float lo, float hi) { return f2bf(lo) | (f2bf(hi) << 16); }
__device__ __forceinline__ float bfl(unsigned w) { return __uint_as_float(w << 16); }
__device__ __forceinline__ float bfh(unsigned w) { return __uint_as_float(w & 0xffff0000u); }
#define XB_TMO      128
#define XB_XCNT(j)  (256  + 64 * (j))
#define XB_XSUB(j)  (1280 + 64 * (j))
#define XB_XGEN(j)  (2304 + 64 * (j))
#define XB_TOP      3328
#define XB_TOPGEN   3392
#define XCD_BAR_WORDS 3456
#define XB_SPIN_CAP (1u << 18)

__device__ __forceinline__ unsigned xb_ld(unsigned* p)              { return __hip_atomic_load(p, __ATOMIC_RELAXED, __HIP_MEMORY_SCOPE_AGENT); }
__device__ __forceinline__ unsigned xb_add(unsigned* p, unsigned v) { return __hip_atomic_fetch_add(p, v, __ATOMIC_RELAXED, __HIP_MEMORY_SCOPE_AGENT); }
__device__ __forceinline__ unsigned xb_xcc_id() { return (unsigned)__builtin_amdgcn_s_getreg((3 << 11) | 20) & 0xFu; }
#define XB_SPIN(cond, bar) do { unsigned _sp = 0; while (cond) { __builtin_amdgcn_s_sleep(1); \
    if ((++_sp & 255u) == 0u) { if (xb_ld(&(bar)[XB_TMO])) break; if (_sp > XB_SPIN_CAP) { atomicAdd(&(bar)[XB_TMO], 1u); break; } } } } while (0)

struct XcdBarrier {
    unsigned* bar; unsigned x;
    volatile LAS unsigned* st;
};

__device__ __forceinline__ XcdBarrier xcd_barrier_post(unsigned* bar, volatile LAS unsigned* st, bool t0) {
    XcdBarrier b; b.bar = bar; b.x = xb_xcc_id(); b.st = st;
    if (t0) (void)xb_add(&bar[XB_XCNT(b.x)], 1u);
    return b;
}
__device__ __forceinline__ void xcd_barrier_complete(unsigned* bar, unsigned x, unsigned& nloc, unsigned& nx) {
    const unsigned G = gridDim.x * gridDim.y * gridDim.z;
    unsigned sum, cnt, mine, sp = 0u;
    for (;;) {
        sum = 0u; cnt = 0u; mine = 0u;
#pragma unroll
        for (unsigned j = 0; j < 16; ++j) { const unsigned c = xb_ld(&bar[XB_XCNT(j)]); sum += c; cnt += (c > 0u) ? 1u : 0u; mine = (j == x) ? c : mine; }
        if (sum == G) break;
        __builtin_amdgcn_s_sleep(1);
        if ((++sp & 255u) == 0u) { if (xb_ld(&bar[XB_TMO])) break; if (sp > XB_SPIN_CAP) { atomicAdd(&bar[XB_TMO], 1u); break; } }
    }
    nloc = mine > 0u ? mine : 1u; nx = cnt > 0u ? cnt : 1u;
}

__device__ __forceinline__ void xcd_barrier(const XcdBarrier& b, bool t0) {
    asm volatile("s_waitcnt vmcnt(0)" ::: "memory");
    __syncthreads();
    if (t0) {
        unsigned* bar = b.bar;
        __builtin_amdgcn_s_waitcnt(0);
        unsigned nloc = b.st[0], nx = b.st[1];
        if (nloc == 0u) { xcd_barrier_complete(bar, b.x, nloc, nx); b.st[0] = nloc; b.st[1] = nx; }
        const unsigned old = xb_add(&bar[XB_XSUB(b.x)], 1u);
        const unsigned gen = old / nloc;
        if (old + 1u == (gen + 1u) * nloc) {
            __builtin_amdgcn_fence(__ATOMIC_RELEASE, "agent");
            asm volatile("s_waitcnt vmcnt(0)" ::: "memory");
            const unsigned og = xb_add(&bar[XB_TOP], 1u);
            const unsigned tg = og / nx;
            if (og + 1u == (tg + 1u) * nx) xb_add(&bar[XB_TOPGEN], 1u);
            else XB_SPIN(xb_ld(&bar[XB_TOPGEN]) == tg, bar);
            __builtin_amdgcn_fence(__ATOMIC_ACQUIRE, "agent");
            xb_add(&bar[XB_XGEN(b.x)], 1u);
            asm volatile("s_waitcnt vmcnt(0)" ::: "memory");
        } else {
            XB_SPIN(xb_ld(&bar[XB_XGEN(b.x)]) == gen, bar);
            __builtin_amdgcn_fence(__ATOMIC_ACQUIRE, "agent");
            asm volatile("s_waitcnt vmcnt(0)" ::: "memory");
        }
    }
    __syncthreads();
}

struct Args { const float* in[17]; float* out; unsigned char* ws; int ph_lo, ph_hi; };
struct Frame {
    LAS unsigned char* lds;
    int tid, lane, wave, gw, NGW;
    unsigned char* ws; unsigned char* dout;
};
__device__ __forceinline__ float wave_sum(float v) {
#pragma unroll
    for (int o = 1; o < 64; o <<= 1) v += __shfl_xor(v, o);
    return v;
}
__device__ __forceinline__ void p0_mod_partials(Frame& F, const Args& A) {
    LAS float* sc = (LAS float*)(F.lds + RING_OFF);
    for (int i = F.tid; i < 2 * D; i += NWAVES * 64) { const float c = i < D ? A.in[2][i] : A.in[3][i - D]; sc[i] = c / (1.0f + expf(-c)); }
    __syncthreads();
    const float* wada = A.in[4]; float* modp = (float*)(F.ws + WS_MODP);
    for (int it = F.gw; it < 64 * 96; it += F.NGW) { const int kk = it / 96, cc = it % 96;
        const f32x4* wp = (const f32x4*)(wada + (size_t)(kk * 64) * (6 * D) + cc * 256) + F.lane;
        f32x4 a0 = {0.f, 0.f, 0.f, 0.f}, a1 = {0.f, 0.f, 0.f, 0.f};
#pragma unroll 16
        for (int k = 0; k < 64; ++k) { const f32x4 w = __builtin_nontemporal_load(wp + (size_t)k * (6 * D / 4)); const float s0 = sc[kk * 64 + k], s1 = sc[D + kk * 64 + k]; a0 += w * s0; a1 += w * s1; }
        ((f32x4*)(modp + (size_t)(kk * 2 + 0) * (6 * D) + cc * 256))[F.lane] = a0;
        ((f32x4*)(modp + (size_t)(kk * 2 + 1) * (6 * D) + cc * 256))[F.lane] = a1;
    }
    __syncthreads();
}
__device__ __forceinline__ unsigned pk4_fp8(float a, float b, float c, float d) { int w = 0; w = __builtin_amdgcn_cvt_pk_fp8_f32(a, b, w, false); w = __builtin_amdgcn_cvt_pk_fp8_f32(c, d, w, true); return (unsigned)w; }
template <int MODE> __device__ __forceinline__ int wt_row(int n) {
    if (MODE == 1) { const int d = n & 127;
        return (n & ~255) + 128 * ((d >> 2) & 1) + 32 * (2 * ((n >> 7) & 1) + ((d >> 5) & 1)) + 8 * ((d >> 3) & 3) + 4 * (d >> 6) + (d & 3); }
    if (MODE == 2 || MODE == 3) { const int c = n & 127;
        return 2 * (n & ~127) + 128 * ((c >> 2) & 1) + 32 * (c >> 5) + 8 * ((c >> 3) & 3) + (c & 3) + (MODE == 3 ? 4 : 0); }
    if (MODE == 4) { const int c = n & 255;
        return (n & ~255) + 128 * ((c >> 3) & 1) + 32 * (c >> 6) + 8 * ((c >> 4) & 3) + (c & 7); }
    return n;
}
template <int MODE> __device__ __forceinline__ void p0_transpose_item(const float* W, int K, int N, bf16* WT, int row_off, LAS float* scr, int item, int lane, float ws_ = 1.f) {
    const int nblk = N / 16, kb = item / nblk, nb = item % nblk, k0 = 128 * kb, n0 = 16 * nb;
    float ld_[32];
#pragma unroll
    for (int i = 0; i < 32; ++i) ld_[i] = W[(size_t)(k0 + 4 * i + (lane >> 4)) * N + n0 + (lane & 15)];
#pragma unroll
    for (int i = 0; i < 32; ++i) scr[(4 * i + (lane >> 4)) * 17 + (lane & 15)] = ld_[i];
    LDS_WAIT(); asm volatile("" ::: "memory");
    const int c = lane & 15;
#pragma unroll
    for (int j = 0; j < 4; ++j) { const int n = (lane >> 4) + 4 * j; const LAS float* s = scr + (8 * c) * 17 + n;
        v4u o; o.x = pk2(ws_ * s[0 * 17], ws_ * s[1 * 17]); o.y = pk2(ws_ * s[2 * 17], ws_ * s[3 * 17]); o.z = pk2(ws_ * s[4 * 17], ws_ * s[5 * 17]); o.w = pk2(ws_ * s[6 * 17], ws_ * s[7 * 17]);
        *(v4u*)(WT + (size_t)(row_off + wt_row<MODE>(n0 + n)) * K + k0 + 8 * c) = o; }
    LDS_WAIT(); asm volatile("" ::: "memory");
}
template <int MODE, bool KP = false> __device__ __forceinline__ void p0_transpose_item8(const float* W, int K, int N, unsigned char* WT, int row_off, LAS float* scr, int item, int lane, float ws_ = 64.f) {
    const int nblk = N / 16, kb = item / nblk, nb = item % nblk, k0 = 128 * kb, n0 = 16 * nb;
    float ld_[32];
#pragma unroll
    for (int i = 0; i < 32; ++i) ld_[i] = W[(size_t)(k0 + 4 * i + (lane >> 4)) * N + n0 + (lane & 15)];
#pragma unroll
    for (int i = 0; i < 32; ++i) scr[(4 * i + (lane >> 4)) * 17 + (lane & 15)] = ld_[i];
    LDS_WAIT(); asm volatile("" ::: "memory");
    const int c = lane & 15;
#pragma unroll
    for (int j = 0; j < 4; ++j) { const int n = (lane >> 4) + 4 * j; const LAS float* s = scr + (8 * c) * 17 + n;
        v2u o; o.x = pk4_fp8(ws_ * s[0 * 17], ws_ * s[1 * 17], ws_ * s[2 * 17], ws_ * s[3 * 17]); o.y = pk4_fp8(ws_ * s[4 * 17], ws_ * s[5 * 17], ws_ * s[6 * 17], ws_ * s[7 * 17]);
        unsigned char* dp = WT + (size_t)(row_off + wt_row<MODE>(n0 + n)) * K + k0;
        if constexpr (KP) { const int pos = 32 * (c >> 2) + 16 * (c & 1) + 4 * ((c >> 1) & 1);
            *(unsigned*)(dp + pos) = o.x; *(unsigned*)(dp + pos + 8) = o.y; }
        else *(v2u*)(dp + 8 * c) = o; }
    LDS_WAIT(); asm volatile("" ::: "memory");
}
template <int PART> __device__ __forceinline__ void p0_weights(Frame& F, const Args& A, int gw_ = -1, int ngw_ = 0) {
    LAS float* scr = (LAS float*)(F.lds + RING_OFF + F.wave * 16384);
    unsigned char* w8 = F.ws + WS_W8; bf16* wf = (bf16*)(F.ws + WS_WF); bf16* wau = (bf16*)(F.ws + WS_WAU); bf16* wfu = (bf16*)(F.ws + WS_WFU); bf16* wmix = (bf16*)(F.ws + WS_WMIX); bf16* wgu = (bf16*)(F.ws + WS_WGU); bf16* wd = (bf16*)(F.ws + WS_WD);
    constexpr int I_IN = (D / 128) * (INW / 16), I_AU = (1024 / 128) * (D / 16), I_MIX = (D / 128) * (D / 16), I_G = (D / 128) * (FF / 16), I_D = (FF / 128) * (D / 16);
    constexpr int NITEMS = I_IN + 2 * I_AU + I_MIX + 2 * I_G + I_D;
    constexpr int IT_LO = PART == 0 ? 0 : (PART == 1 ? NITEMS - I_D : NITEMS - I_D / 2), IT_HI = PART == 0 ? NITEMS - I_D : (PART == 1 ? NITEMS - I_D / 2 : NITEMS);
    const int gw0 = gw_ >= 0 ? gw_ : F.gw, ngw0 = gw_ >= 0 ? ngw_ : F.NGW;
    for (int it = IT_LO + gw0; it < IT_HI; it += ngw0) {
        int r = it;
        if (r < I_IN) { const int nb = (r % (INW / 16)) >> 1;
            if (nb < 6144 / 32) p0_transpose_item8<1>(A.in[6], D, INW, w8, 0, scr, r, F.lane); else if (nb < 9216 / 32) p0_transpose_item8<4>(A.in[6], D, INW, w8, 0, scr, r, F.lane);
            else if (nb < 10240 / 32) p0_transpose_item<4>(A.in[6], D, INW, wf, -9216, scr, r, F.lane); else p0_transpose_item8<4>(A.in[6], D, INW, w8, -1024, scr, r, F.lane, 64.f * 1.4426950408889634f);
            continue; } r -= I_IN;
        if (r < I_AU) { p0_transpose_item8<4, true>(A.in[7], 1024, D, (unsigned char*)wau, 0, scr, r, F.lane, 32.f); continue; } r -= I_AU;
        if (r < I_AU) { p0_transpose_item<4>(A.in[8], 1024, D, wfu, 0, scr, r, F.lane, 0.00390625f);     continue; } r -= I_AU;
        if (r < I_MIX) { p0_transpose_item<4>(A.in[9], D, D, wmix, 0, scr, r, F.lane); continue; } r -= I_MIX;
        if (r < I_G) { p0_transpose_item8<2>(A.in[12], D, FF, (unsigned char*)wgu, 0, scr, r, F.lane, 64.f * 1.4426950408889634f)    ; continue; } r -= I_G;
        if (r < I_G) { p0_transpose_item8<3>(A.in[13], D, FF, (unsigned char*)wgu, 0, scr, r, F.lane, 64.f); continue; } r -= I_G;
        p0_transpose_item8<4>(A.in[14], FF, D, (unsigned char*)wd, 0, scr, r, F.lane, 128.f);
    }
}
__device__ __forceinline__ void p0_tables(Frame& F) {
    const int gt = F.gw * 64 + F.lane, NGT = F.NGW * 64;
    unsigned* rope = (unsigned*)(F.ws + WS_ROPE);
    for (int i = gt; i < S0 * 64; i += NGT) { const int pos = i >> 6, d = i & 63;
        const float inv = powf(10000.0f, -(float)d / 64.0f); const float ang = (float)pos * inv;
        const double tr = (double)ang * 0.15915494309189535; const float fr_ = (float)(tr - floor(tr));
        float sn, cs; sincospif(2.0f * fr_, &sn, &cs); rope[(size_t)i] = pk2(cs, sn); }
    { float* tw = (float*)(F.ws + WS_TW); for (int i = gt; i < S0; i += NGT) { float sn, cs; sincospif((float)i * (2.0f / (float)S0), &sn, &cs); tw[2 * i] = cs; tw[2 * i + 1] = sn; } }
    bf16* c256 = (bf16*)(F.ws + WS_C256); bf16* d128 = (bf16*)(F.ws + WS_D128); bf16* d64 = (bf16*)(F.ws + WS_D64);
    for (int i = gt; i < 512 * 256; i += NGT) { const int r = i >> 8, c = i & 255, ri = r >> 8, cp = r & 255;
        float sn, cs; sincospif((float)((c * cp) & 255) * (1.0f / 128.0f), &sn, &cs); c256[i] = (bf16)f2bf(ri ? -sn : cs); }
    for (int i = gt; i < 256 * 256; i += NGT) { const int r = i >> 8, c = i & 255, ro = r >> 7, ka = r & 127, ri = c >> 7, sh = c & 127;
        float sn, cs; sincospif((float)((ka * sh) & 127) * (1.0f / 64.0f), &sn, &cs);
        d128[i] = (bf16)f2bf(ro == ri ? cs : (ro == 0 ? sn : -sn));
        float v = 0.f; if (r < 64 && sh < 64) { float s2, c2; sincospif((float)((r * sh) & 63) * (1.0f / 32.0f), &s2, &c2); v = ri ? s2 : c2; }
        d64[i] = (bf16)f2bf(v); }
}
__device__ __forceinline__ void p1_mod_reduce(Frame& F, const Args& A) {
    const float* modp = (const float*)(F.ws + WS_MODP); float* mod = (float*)(F.ws + WS_MOD); const float* bada = A.in[5];
    for (int i = F.gw * 64 + F.lane; i < 2 * 6 * D; i += F.NGW * 64) { const int b = i / (6 * D), col = i % (6 * D); float s = bada[col];
        for (int kk = 0; kk < 64; ++kk) s += modp[(size_t)(kk * 2 + b) * (6 * D) + col];
        mod[i] = s; }
}
__device__ __forceinline__ void row_stats(const f32x4 (&v)[16], float& mean, float& rstd) {
    float s = 0.f;
#pragma unroll
    for (int j = 0; j < 16; ++j) s += (v[j][0] + v[j][1]) + (v[j][2] + v[j][3]);
    mean = wave_sum(s) * (1.0f / D); float q = 0.f;
#pragma unroll
    for (int j = 0; j < 16; ++j) { const f32x4 d = v[j] - mean; q += (d[0] * d[0] + d[1] * d[1]) + (d[2] * d[2] + d[3] * d[3]); }
    rstd = 1.0f / sqrtf(wave_sum(q) * (1.0f / D) + LN_EPS);
}
__device__ __forceinline__ void p2_ln_mod(Frame& F, const Args& A) {
    const float* mod = (const float*)(F.ws + WS_MOD); bf16* H = (bf16*)(F.ws + WS_H);
    f32x4 nx[16];
    { const int row = F.gw; const f32x4* xr = (const f32x4*)(row >= S0 ? A.in[1] + (size_t)(row - S0) * D : A.in[0] + (size_t)row * D) + F.lane;
#pragma unroll
      for (int j = 0; j < 16; ++j) nx[j] = __builtin_nontemporal_load(xr + 64 * j); }
    asm volatile("" ::: "memory");
    p0_tables(F);
    for (int row = F.gw; row < M; row += F.NGW) { const int b = row >= S0;
        const f32x4* sh = (const f32x4*)(mod + b * 6 * D) + F.lane; const f32x4* sc = (const f32x4*)(mod + b * 6 * D + D) + F.lane;
        f32x4 v[16];
#pragma unroll
        for (int j = 0; j < 16; ++j) v[j] = nx[j];
        { const int rn = row + F.NGW; if (rn < M) { const f32x4* xr = (const f32x4*)(rn >= S0 ? A.in[1] + (size_t)(rn - S0) * D : A.in[0] + (size_t)rn * D) + F.lane;
#pragma unroll
            for (int j = 0; j < 16; ++j) nx[j] = __builtin_nontemporal_load(xr + 64 * j); } }
        float mean, rstd; row_stats(v, mean, rstd);
        v2u* o = (v2u*)(H + (size_t)row * D) + F.lane; unsigned* o8 = (unsigned*)(F.ws + WS_H8 + (size_t)row * D) + F.lane;
#pragma unroll
        for (int j = 0; j < 16; ++j) { const f32x4 y = (v[j] - mean) * rstd * (sc[64 * j] + 1.0f) + sh[64 * j]; v2u w; w.x = pk2(y[0], y[1]); w.y = pk2(y[2], y[3]); o[64 * j] = w; o8[64 * j] = pk4_fp8(y[0], y[1], y[2], y[3]); }
    }
}
typedef _Float16 h16x2 __attribute__((ext_vector_type(2)));
__device__ __forceinline__ unsigned pk2_h(float a, float b) { typedef float f2_ __attribute__((ext_vector_type(2))); const h16x2 h = __builtin_convertvector((f2_){a, b}, h16x2); return __builtin_bit_cast(unsigned, h); }
__device__ __forceinline__ float hlo(unsigned w) { return (float)__builtin_bit_cast(h16x2, w)[0]; }
__device__ __forceinline__ float hhi(unsigned w) { return (float)__builtin_bit_cast(h16x2, w)[1]; }
__device__ __forceinline__ void p13_ln1(Frame& F, const Args& A) {
    const float* mod = (const float*)(F.ws + WS_MOD); bf16* H = (bf16*)(F.ws + WS_H);
    f32x4 nx[16];
    { const int row = F.gw; const f32x4* xin = (const f32x4*)(row >= S0 ? A.in[1] + (size_t)(row - S0) * D : A.in[0] + (size_t)row * D) + F.lane;
#pragma unroll
      for (int j = 0; j < 16; ++j) nx[j] = __builtin_nontemporal_load(xin + 64 * j); }
    for (int row = F.gw; row < M; row += F.NGW) { const int b = row >= S0;
        v2u* xr = (v2u*)(F.ws + WS_X1H + (size_t)row * D * 2) + F.lane;
        const v2u* c1 = (const v2u*)(F.ws + WS_C1 + (size_t)row * D * 2) + F.lane;
        const f32x4* g1 = (const f32x4*)A.in[10] + F.lane; const f32x4* b1 = (const f32x4*)A.in[11] + F.lane;
        const f32x4* sh = (const f32x4*)(mod + b * 6 * D + 3 * D) + F.lane; const f32x4* sc = (const f32x4*)(mod + b * 6 * D + 4 * D) + F.lane;
        f32x4 v[16];
#pragma unroll
        for (int j = 0; j < 16; ++j) { const v2u c = __builtin_nontemporal_load(c1 + 64 * j); v[j] = nx[j] * ALPHA + (f32x4){bfl(c.x), bfh(c.x), bfl(c.y), bfh(c.y)}; }
        { const int rn = row + F.NGW; if (rn < M) { const f32x4* xin = (const f32x4*)(rn >= S0 ? A.in[1] + (size_t)(rn - S0) * D : A.in[0] + (size_t)rn * D) + F.lane;
#pragma unroll
            for (int j = 0; j < 16; ++j) nx[j] = __builtin_nontemporal_load(xin + 64 * j); } }
        float mean, rstd; row_stats(v, mean, rstd);
#pragma unroll
        for (int j = 0; j < 16; ++j) { v[j] = (v[j] - mean) * rstd * g1[64 * j] + b1[64 * j]; v2u w; w.x = pk2_h(v[j][0], v[j][1]); w.y = pk2_h(v[j][2], v[j][3]); __builtin_nontemporal_store(w, xr + 64 * j); }
        row_stats(v, mean, rstd);
        unsigned* o8 = (unsigned*)((unsigned char*)H + (size_t)row * D) + F.lane;
#pragma unroll
        for (int j = 0; j < 16; ++j) { const f32x4 y = (v[j] - mean) * rstd * (sc[64 * j] + 1.0f) + sh[64 * j]; o8[64 * j] = pk4_fp8(y[0], y[1], y[2], y[3]); }
    }
}
__device__ __forceinline__ void p16_ln2(Frame& F, const Args& A) {
    float* out = (float*)F.dout;
    v2u nc[16], nxh[16];
    { const int row = F.gw; const v2u* c2 = (const v2u*)(F.ws + WS_C2 + (size_t)row * D * 2) + F.lane; const v2u* x1 = (const v2u*)(F.ws + WS_X1H + (size_t)row * D * 2) + F.lane;
#pragma unroll
      for (int j = 0; j < 16; ++j) { nc[j] = __builtin_nontemporal_load(c2 + 64 * j); nxh[j] = __builtin_nontemporal_load(x1 + 64 * j); } }
    for (int row = F.gw; row < M; row += F.NGW) {
        f32x4* xr = (f32x4*)(out + (size_t)row * D) + F.lane;
        const f32x4* g2 = (const f32x4*)A.in[15] + F.lane; const f32x4* b2 = (const f32x4*)A.in[16] + F.lane;
        f32x4 v[16];
#pragma unroll
        for (int j = 0; j < 16; ++j) { const v2u c = nc[j], x = nxh[j]; v[j] = (f32x4){hlo(x.x), hhi(x.x), hlo(x.y), hhi(x.y)} * ALPHA + (f32x4){bfl(c.x), bfh(c.x), bfl(c.y), bfh(c.y)}; }
        { const int rn = row + F.NGW; if (rn < M) { const v2u* c2 = (const v2u*)(F.ws + WS_C2 + (size_t)rn * D * 2) + F.lane; const v2u* x1 = (const v2u*)(F.ws + WS_X1H + (size_t)rn * D * 2) + F.lane;
#pragma unroll
            for (int j = 0; j < 16; ++j) { nc[j] = __builtin_nontemporal_load(c2 + 64 * j); nxh[j] = __builtin_nontemporal_load(x1 + 64 * j); } } }
        float mean, rstd; row_stats(v, mean, rstd);
#pragma unroll
        for (int j = 0; j < 16; ++j) __builtin_nontemporal_store((v[j] - mean) * rstd * g2[64 * j] + b2[64 * j], xr + 64 * j);
    }
}
constexpr int VT_LD = 136;
typedef short v4s_t __attribute__((ext_vector_type(4)));
__device__ __forceinline__ void attn_unit(const bf16* __restrict__ Q, const bf16* __restrict__ Kb, const unsigned char* __restrict__ V, bf16* __restrict__ OG, float* __restrict__ LSE, int unit, int lane, LAS bf16* vt) {
    const int gh = unit / 768; int u = unit - gh * 768;
    const int dsh = 2 * (gh >> 3);
    int seq_off = 0, S = S0; if (u >= 512) { u -= 512; seq_off = S0; S = S1; }
    const int L = S >> dsh, cpc = L >> 5;
    const int r = u / cpc, ch = u - r * cpc;
    const int colbase = gh * 128;
    const int i = lane & 15, h = lane >> 4;
    const int l0 = 32 * ch - 64;
    size_t qrow[2]; bf16x8 qf[2][4];
#pragma unroll
    for (int qt = 0; qt < 2; ++qt) { qrow[qt] = (size_t)seq_off + (size_t)(((32 * ch + 16 * qt + i) << dsh) + r); const bf16* qp = Q + qrow[qt] * AW + colbase + 8 * h;
#pragma unroll
        for (int ks = 0; ks < 4; ++ks) qf[qt][ks] = *(const bf16x8*)(qp + 32 * ks); }
    f32x4 sc[2][10];
    constexpr int KD = 5;
    bf16x8 kf[KD][4];
#define ATT_KLOAD(t_, dst_) do { int lk_ = l0 + 16 * (t_) + i; lk_ = lk_ < 0 ? 0 : (lk_ > L - 1 ? L - 1 : lk_); \
        const bf16* kp_ = Kb + ((size_t)seq_off + (size_t)((lk_ << dsh) + r)) * AW + colbase + 8 * h; \
        _Pragma("unroll") for (int ks = 0; ks < 4; ++ks) dst_[ks] = *(const bf16x8*)(kp_ + 32 * ks); } while (0)
#pragma unroll
    for (int t = 0; t < KD; ++t) ATT_KLOAD(t, kf[t]);
    asm volatile("" ::: "memory");
#pragma unroll
    for (int t = 0; t < 10; ++t) {
#pragma unroll
        for (int qt = 0; qt < 2; ++qt) { f32x4 a = {0.f, 0.f, 0.f, 0.f};
#pragma unroll
            for (int ks = 0; ks < 4; ++ks) a = __builtin_amdgcn_mfma_f32_16x16x32_bf16(kf[t % KD][ks], qf[qt][ks], a, 0, 0, 0);
            sc[qt][t] = a; }
        if (t + KD < 10) { ATT_KLOAD(t + KD, kf[t % KD]); asm volatile("" ::: "memory"); } }
#undef ATT_KLOAD
    v2u vv[8];
#define ATT_VLOAD(c_, dst_) do { _Pragma("unroll") for (int it = 0; it < 8; ++it) { int lk_ = l0 + 32 * (c_) + h + 4 * it; lk_ = lk_ < 0 ? 0 : (lk_ > L - 1 ? L - 1 : lk_); \
        dst_[it] = *(const v2u*)(V + ((size_t)seq_off + (size_t)((lk_ << dsh) + r)) * AW + colbase + 8 * i); } } while (0)
    ATT_VLOAD(0, vv);
    asm volatile("" ::: "memory");
    float mx[2], sum[2];
#pragma unroll
    for (int qt = 0; qt < 2; ++qt) { float m_ = -3.0e38f;
#pragma unroll
        for (int t = 0; t < 10; ++t)
#pragma unroll
            for (int rg = 0; rg < 4; ++rg) { const int c = 4 * h + rg, rel = 16 * t + c - 16 * qt - i, lk = l0 + 16 * t + c;
                const bool valid = (lk >= 0) && (lk < L) && (rel >= 0) && (rel <= 128);
                const float s_ = valid ? sc[qt][t][rg] : -1.0e30f; sc[qt][t][rg] = s_; m_ = fmaxf(m_, s_); }
        m_ = fmaxf(m_, __shfl_xor(m_, 16)); m_ = fmaxf(m_, __shfl_xor(m_, 32)); mx[qt] = m_;
        float su = 0.f;
#pragma unroll
        for (int t = 0; t < 10; ++t)
#pragma unroll
            for (int rg = 0; rg < 4; ++rg) { const float p = __builtin_amdgcn_exp2f(sc[qt][t][rg] - m_); sc[qt][t][rg] = p; su += p; }
        su += __shfl_xor(su, 16); su += __shfl_xor(su, 32); sum[qt] = su; }
    f32x4 o[2][8];
#pragma unroll
    for (int qt = 0; qt < 2; ++qt)
#pragma unroll
        for (int dc = 0; dc < 8; ++dc) o[qt][dc] = (f32x4){0.f, 0.f, 0.f, 0.f};
#pragma unroll
    for (int kk = 0; kk < 5; ++kk) {
#pragma unroll
        for (int it = 0; it < 8; ++it) { const v2u r8 = vv[it];
            const pg8::cvt_f32x2 a0 = __builtin_amdgcn_cvt_pk_f32_fp8((int)r8.x, false), a1 = __builtin_amdgcn_cvt_pk_f32_fp8((int)r8.x, true), a2 = __builtin_amdgcn_cvt_pk_f32_fp8((int)r8.y, false), a3 = __builtin_amdgcn_cvt_pk_f32_fp8((int)r8.y, true);
            v4u wv; wv.x = pk2(a0[0], a0[1]); wv.y = pk2(a1[0], a1[1]); wv.z = pk2(a2[0], a2[1]); wv.w = pk2(a3[0], a3[1]);
            *(LAS v4u*)(vt + (h + 4 * it) * VT_LD + 8 * i) = wv; }
        if (kk + 1 < 5) { ATT_VLOAD(kk + 1, vv); asm volatile("" ::: "memory"); }
        bf16x8 pf[2];
#pragma unroll
        for (int qt = 0; qt < 2; ++qt)
#pragma unroll
            for (int j = 0; j < 8; ++j) pf[qt][j] = (short)f2bf(sc[qt][2 * kk + (j >> 2)][j & 3]);
#pragma unroll
        for (int dc = 0; dc < 8; ++dc) {
            const LAS bf16* rp = vt + (4 * h + (i >> 2)) * VT_LD + 16 * dc + 4 * (i & 3);
            const v4s_t lo = __builtin_amdgcn_ds_read_tr16_b64_v4i16((LAS v4s_t*)rp), hi = __builtin_amdgcn_ds_read_tr16_b64_v4i16((LAS v4s_t*)(rp + 16 * VT_LD));
            const bf16x8 vf = __builtin_shufflevector(lo, hi, 0, 1, 2, 3, 4, 5, 6, 7);
#pragma unroll
            for (int qt = 0; qt < 2; ++qt) o[qt][dc] = __builtin_amdgcn_mfma_f32_16x16x32_bf16(vf, pf[qt], o[qt][dc], 0, 0, 0); }
    }
#undef ATT_VLOAD
#pragma unroll
    for (int qt = 0; qt < 2; ++qt) { const float inv = 0.0625f / sum[qt]; bf16* op = OG + qrow[qt] * AW + colbase + 8 * h;
#pragma unroll
        for (int s2 = 0; s2 < 4; ++s2) { v4u w; w.x = pk2(o[qt][2 * s2][0] * inv, o[qt][2 * s2][1] * inv); w.y = pk2(o[qt][2 * s2][2] * inv, o[qt][2 * s2][3] * inv);
            w.z = pk2(o[qt][2 * s2 + 1][0] * inv, o[qt][2 * s2 + 1][1] * inv); w.w = pk2(o[qt][2 * s2 + 1][2] * inv, o[qt][2 * s2 + 1][3] * inv); *(v4u*)(op + 32 * s2) = w; }
        if (h == 0) LSE[qrow[qt] * 24 + gh] = (mx[qt] + __log2f(sum[qt])) * 0.6931471805599453f; }
}
__device__ __forceinline__ void p_attention(Frame& F) {
    const bf16* Q = (const bf16*)(F.ws + WS_Q); const bf16* Kb = (const bf16*)(F.ws + WS_K); const unsigned char* V = F.ws + WS_V;
    bf16* OG = (bf16*)(F.ws + WS_OG); float* LSE = (float*)(F.ws + WS_LSE);
    LAS bf16* vt = (LAS bf16*)(F.lds + RING_OFF + F.wave * (32 * VT_LD * 2));
    for (int unit = F.gw; unit < 24 * 768; unit += F.NGW) attn_unit(Q, Kb, V, OG, LSE, unit, F.lane, vt);
    __syncthreads();
}
__device__ __forceinline__ void p_combine(Frame& F) {
    const bf16* OG = (const bf16*)(F.ws + WS_OG); const float* LSE = (const float*)(F.ws + WS_LSE); unsigned char* AT = F.dout + DO_ATTN;
    const int hh = F.lane >> 3, cq = F.lane & 7;
    v4u nv[2][3]; float nl[3];
#define PC_LOAD(row_) do { const bf16* p_ = OG + (size_t)(row_) * AW + hh * 128 + cq * 16; \
        _Pragma("unroll") for (int half = 0; half < 2; ++half) _Pragma("unroll") for (int g_ = 0; g_ < 3; ++g_) nv[half][g_] = __builtin_nontemporal_load((const v4u*)(p_ + 1024 * g_ + 8 * half)); \
        _Pragma("unroll") for (int g_ = 0; g_ < 3; ++g_) nl[g_] = LSE[(size_t)(row_) * 24 + 8 * g_ + hh]; } while (0)
    if (F.gw < M) PC_LOAD(F.gw);
    for (int row = F.gw; row < M; row += F.NGW) {
        const float l0 = nl[0], l1 = nl[1], l2 = nl[2];
        v4u cv[2][3];
#pragma unroll
        for (int half = 0; half < 2; ++half)
#pragma unroll
            for (int g_ = 0; g_ < 3; ++g_) cv[half][g_] = nv[half][g_];
        if (row + F.NGW < M) PC_LOAD(row + F.NGW);
        const float mx = fmaxf(l0, fmaxf(l1, l2)); float w0 = __expf(l0 - mx), w1 = __expf(l1 - mx), w2 = __expf(l2 - mx); const float inv = 1.0f / (w0 + w1 + w2); w0 *= inv; w1 *= inv; w2 *= inv;
        v4u o4;
#pragma unroll
        for (int half = 0; half < 2; ++half) {
            const v4u a = cv[half][0], b = cv[half][1], c = cv[half][2];
            v2u o;
            o.x = pk4_fp8(64.f * (w0 * bfl(a.x) + w1 * bfl(b.x) + w2 * bfl(c.x)), 64.f * (w0 * bfh(a.x) + w1 * bfh(b.x) + w2 * bfh(c.x)), 64.f * (w0 * bfl(a.y) + w1 * bfl(b.y) + w2 * bfl(c.y)), 64.f * (w0 * bfh(a.y) + w1 * bfh(b.y) + w2 * bfh(c.y)));
            o.y = pk4_fp8(64.f * (w0 * bfl(a.z) + w1 * bfl(b.z) + w2 * bfl(c.z)), 64.f * (w0 * bfh(a.z) + w1 * bfh(b.z) + w2 * bfh(c.z)), 64.f * (w0 * bfl(a.w) + w1 * bfl(b.w) + w2 * bfl(c.w)), 64.f * (w0 * bfh(a.w) + w1 * bfh(b.w) + w2 * bfh(c.w)));
            o4[2 * half] = o.x; o4[2 * half + 1] = o.y; }
        *(v4u*)(AT + (size_t)row * 1024 + hh * 128 + cq * 16) = o4;
    }
#undef PC_LOAD
}
__device__ __forceinline__ void tr8x8(const v4u (&in)[8], v4u (&out)[8]) {
    unsigned a[8][8];
#pragma unroll
    for (int e = 0; e < 8; ++e) { a[e][0] = in[e].x & 0xffffu; a[e][1] = in[e].x >> 16; a[e][2] = in[e].y & 0xffffu; a[e][3] = in[e].y >> 16; a[e][4] = in[e].z & 0xffffu; a[e][5] = in[e].z >> 16; a[e][6] = in[e].w & 0xffffu; a[e][7] = in[e].w >> 16; }
#pragma unroll
    for (int q = 0; q < 8; ++q) { out[q].x = a[0][q] | (a[1][q] << 16); out[q].y = a[2][q] | (a[3][q] << 16); out[q].z = a[4][q] | (a[5][q] << 16); out[q].w = a[6][q] | (a[7][q] << 16); }
}

__device__ __forceinline__ int lane_id_now() { int l; asm volatile("v_mbcnt_lo_u32_b32 %0, -1, 0\n\tv_mbcnt_hi_u32_b32 %0, -1, %0" : "=v"(l)); return l; }
__global__ void __launch_bounds__(NWAVES * 64, 2) enc_fwd(Args args) {
    extern __shared__ __attribute__((aligned(16))) unsigned char lds[];
#define HW_SLOT() ((int)__builtin_amdgcn_s_getreg((5 << 11) | 4) & 63)
#define TID() (64 * (int)__builtin_amdgcn_readfirstlane((int)((volatile LAS unsigned char*)((LAS unsigned char*)lds + MISC_OFF + 64))[HW_SLOT()]) + lane_id_now())
    { const int t0 = threadIdx.x; for (int u = t0; u < (LDS_BYTES - LDSCTL_OFF) / 4; u += NWAVES * 64) ((LAS unsigned*)((LAS unsigned char*)lds + LDSCTL_OFF))[u] = 0u; }
    __syncthreads();
    if ((threadIdx.x & 63) == 0) ((volatile LAS unsigned char*)((LAS unsigned char*)lds + MISC_OFF + 64))[HW_SLOT()] = (unsigned char)(threadIdx.x >> 6);
    __syncthreads();
#define MKF() Frame F; { int t_ = TID(); asm volatile("" : "+v"(t_)); F.lds = (LAS unsigned char*)lds; F.tid = t_; F.lane = t_ & 63; F.wave = __builtin_amdgcn_readfirstlane(t_ >> 6); \
        const int G_ = gridDim.x, bx_ = blockIdx.x; const int vcu_ = (G_ % 8 == 0) ? (bx_ % 8) * (G_ / 8) + bx_ / 8 : bx_; F.gw = vcu_ * NWAVES + F.wave; F.NGW = G_ * NWAVES; F.ws = args.ws; F.dout = (unsigned char*)args.out; }
    unsigned* ctl = (unsigned*)(args.ws + WS_CTL);
#if MK_ONE_LAUNCH
    (void)xcd_barrier_post(ctl + CW_BAR, (volatile LAS unsigned*)((LAS unsigned char*)lds + MISC_OFF) + 8, TID() == 0);
#define IN(k) true
#define SEAM(k) do { XcdBarrier b_; b_.bar = (unsigned*)(args.ws + WS_CTL) + CW_BAR; b_.x = xb_xcc_id(); b_.st = (volatile LAS unsigned*)((LAS unsigned char*)lds + MISC_OFF) + 8; xcd_barrier(b_, TID() == 0); } while (0)
#else
    const int lo = args.ph_lo, hi = args.ph_hi;
#define IN(k) (lo <= (k) && (k) < hi)
#define SEAM(k) do { } while (0)
#endif
#define HB ((bf16*)(args.ws + WS_H))
#define WSP(off) (args.ws + (off))
#define DOP(off) ((unsigned char*)args.out + (off))
#define LDSP ((LAS unsigned char*)lds + RING_OFF)
#define GRID_ ((int)gridDim.x)
    const float* const mod = (const float*)(args.ws + WS_MOD);
    float* const out = args.out;

    if (IN(0)) { MKF(); p0_mod_partials(F, args); p0_weights<0>(F, args); } SEAM(0);
    if (IN(1)) { MKF(); p1_mod_reduce(F, args); p0_weights<1>(F, args); if (GRID_ <= 64) p0_weights<3>(F, args); } SEAM(1);
    if (IN(2)) { MKF(); p2_ln_mod(F, args); } SEAM(2);
    if (IN(3)) {
        { pg8::Gemm g{(const bf16*)(args.ws + WS_H8), (const bf16*)(args.ws + WS_W8), M, 9216, D}; pg8::StaticOrder S; S.init(M, 9216, GRID_, (int)blockIdx.x);
          pg8::EpiQKVF E{(bf16*)(args.ws + WS_Q), (bf16*)(args.ws + WS_K), (bf16*)(args.ws + WS_V), (bf16*)(args.ws + WS_F), (const float*)(args.ws + WS_ROPE), 0};
          pg8::gemm_phase<pg8::EpiQKVF, pg8::StaticOrder, true, true, true>(LDSP, g, S, E, TID()); }
        { pg8::Gemm g{HB, (const bf16*)(args.ws + WS_WF), M, 1024, D}; pg8::StaticOrder S; S.init(M, 1024, GRID_, ((int)blockIdx.x + GRID_ / 2) % GRID_);
          pg8::EpiQKVF E{(bf16*)(args.ws + WS_Q), (bf16*)(args.ws + WS_K), (bf16*)(args.ws + WS_V), (bf16*)(args.ws + WS_F), (const float*)(args.ws + WS_ROPE), 36};
          pg8::gemm_phase<pg8::EpiQKVF, pg8::StaticOrder, true, true>(LDSP, g, S, E, TID()); }
    } SEAM(3);
    if (IN(4)) {
        { MKF(); p_attention(F); }
        { pg8::Gemm g{(const bf16*)(args.ws + WS_C256), (const bf16*)(args.ws + WS_F), 512, 65536, 256}; pg8::DftOrder S; S.init(512, 65536, GRID_, (int)blockIdx.x); S.tsh = 6; S.gjump = (size_t)M * 512 - (size_t)64 * 1024; S.brow_bytes = 128 * 512;
          pg8::EpiA1 E{(bf16*)((unsigned char*)args.out + DO_A1), 6, 7, 0.0625f};
          pg8::gemm_phase<pg8::EpiA1, pg8::DftOrder, false, false>(LDSP, g, S, E, TID()); }
        { pg8::Gemm g{(const bf16*)(args.ws + WS_C256), (const bf16*)(args.ws + WS_F) + (size_t)S0 * 256, 512, 32768, 256}; pg8::DftOrder S; S.init(512, 32768, GRID_, (int)blockIdx.x); S.tsh = 5; S.gjump = (size_t)M * 512 - (size_t)32 * 1024; S.brow_bytes = 64 * 512;
          pg8::EpiA1 E{(bf16*)((unsigned char*)args.out + DO_A1) + (size_t)131072 * 256, 5, 6, 0.0625f};
          pg8::gemm_phase<pg8::EpiA1, pg8::DftOrder, false, false>(LDSP, g, S, E, TID()); }
    } SEAM(4);
    if (IN(6)) {
        { MKF(); p_combine(F); }
        { pg8::Gemm g{(const bf16*)(args.ws + WS_D128), (const bf16*)((unsigned char*)args.out + DO_A1), 256, 196608, 256}; pg8::StaticOrder S; S.init(256, 196608, GRID_, (int)blockIdx.x);
          pg8::EpiTwT E{(bf16*)((unsigned char*)args.out + DO_A2), 0.08838834764831845f, (const float*)(args.ws + WS_TW)};
          pg8::gemm_phase<pg8::EpiTwT, pg8::StaticOrder, false, false>(LDSP, g, S, E, TID()); }
    } SEAM(6);
    if (IN(7)) {
        { pg8::Gemm g{(const bf16*)(args.ws + WS_H8), (const bf16*)(args.ws + WS_W8 + (size_t)9216 * D), M, NGATE, D}; pg8::StaticOrder S; S.init(M, NGATE, GRID_, (int)blockIdx.x);
          pg8::EpiGates E{args.ws + WS_G};
          pg8::gemm_phase<pg8::EpiGates, pg8::StaticOrder, true, true, true>(LDSP, g, S, E, TID()); }
    }
    if (IN(8)) {
        { pg8::Gemm g{(const bf16*)((unsigned char*)args.out + DO_A2), (const bf16*)(args.ws + WS_D128), 131072, 256, 256}; pg8::StaticOrder S; S.init(131072, 256, GRID_, (int)blockIdx.x);
          pg8::EpiFour E{(bf16*)((unsigned char*)args.out + DO_FOUR), 0, 128, 0.08838834764831845f};
          pg8::gemm_phase<pg8::EpiFour, pg8::StaticOrder, true, false>(LDSP, g, S, E, TID()); }
        { pg8::Gemm g{(const bf16*)((unsigned char*)args.out + DO_A2) + (size_t)131072 * 256, (const bf16*)(args.ws + WS_D64), 131072, 256, 256}; pg8::StaticOrder S; S.init(131072, 256, GRID_, (int)blockIdx.x);
          pg8::EpiFour E{(bf16*)((unsigned char*)args.out + DO_FOUR), S0, 64, 0.125f};
          pg8::gemm_phase<pg8::EpiFour, pg8::StaticOrder, true, false>(LDSP, g, S, E, TID()); }
    } SEAM(8);
    if (IN(10)) {
        { pg8::Gemm g{(const bf16*)((unsigned char*)args.out + DO_ATTN), (const bf16*)(args.ws + WS_WAU), M, D, 1024, 0x72727272, 0x79797979}; pg8::StaticOrder S; S.init(M, D, GRID_, (int)blockIdx.x);
          pg8::EpiBranch<0> E{args.ws + WS_G, HB, args.ws + WS_MA};
          pg8::gemm_phase<pg8::EpiBranch<0>, pg8::StaticOrder, true, true, true>(LDSP, g, S, E, TID()); }
        { pg8::Gemm g{(const bf16*)((unsigned char*)args.out + DO_FOUR), (const bf16*)(args.ws + WS_WFU), M, D, 1024}; pg8::StaticOrder S; S.init(M, D, GRID_, (int)blockIdx.x);
          pg8::EpiBranch<1> E{args.ws + WS_G, HB, args.ws + WS_MA};
          pg8::gemm_phase<pg8::EpiBranch<1>, pg8::StaticOrder, true, true>(LDSP, g, S, E, TID()); }
    } SEAM(10);
    if (IN(11)) {
        pg8::Gemm g{HB, (const bf16*)(args.ws + WS_WMIX), M, D, D}; pg8::StaticOrder S; S.init(M, D, GRID_, (int)blockIdx.x);
        pg8::EpiContrib E{(bf16*)(args.ws + WS_C1), mod + 2 * D, mod + 6 * D + 2 * D};
        pg8::gemm_phase<pg8::EpiContrib, pg8::StaticOrder, true, true>(LDSP, g, S, E, TID());
    } SEAM(11);
    if (IN(12)) { MKF(); p13_ln1(F, args); } SEAM(12);
    if (IN(13)) {
        pg8::Gemm g{HB, (const bf16*)(args.ws + WS_WGU), M, NGU, D, 0x79797979, 0x7f7f7f7f}; pg8::StaticOrder S; S.init(M, NGU, GRID_, (int)blockIdx.x);
        pg8::EpiGU E{(unsigned char*)(args.ws + WS_HID)};
        pg8::gemm_phase<pg8::EpiGU, pg8::StaticOrder, true, true, true>(LDSP, g, S, E, TID());
        if ((int)blockIdx.x >= 64 && GRID_ > 64) { MKF(); p0_weights<3>(F, args, ((int)blockIdx.x - 64) * NWAVES + F.wave, (GRID_ - 64) * NWAVES); }
    } SEAM(13);
    if (IN(14)) {
        pg8::Gemm g{(const bf16*)(args.ws + WS_HID), (const bf16*)(args.ws + WS_WD), M, D, FF, 0x78787878, 0x7b7b7b7b}; pg8::StaticOrder S; S.init(M, D, GRID_, (int)blockIdx.x);
        pg8::EpiContrib E{(bf16*)(args.ws + WS_C2), mod + 5 * D, mod + 6 * D + 5 * D};
        pg8::gemm_phase<pg8::EpiContrib, pg8::StaticOrder, true, true, true>(LDSP, g, S, E, TID());
    } SEAM(14);
    if (IN(15)) { MKF(); p16_ln2(F, args); }
#undef IN
#undef SEAM
}

extern "C" void kernel_launch(void* const* d_in, const int* in_sizes, int n_in, void* d_out, int out_size, void* d_ws, size_t ws_size, hipStream_t stream) {
    static int grid = 0;
    if (grid == 0) {
        if (n_in != 17 || out_size != M * D || ws_size < WS_END) { fprintf(stderr, "kernel_launch: unexpected shapes (n_in %d, out %d, ws %zu); nothing launched\n", n_in, out_size, ws_size); grid = -1; return; }
        int dev = 0, cus = 0;
        if (hipGetDevice(&dev) != hipSuccess || hipDeviceGetAttribute(&cus, hipDeviceAttributeMultiprocessorCount, dev) != hipSuccess) { grid = -1; return; }
        if (hipFuncSetAttribute((const void*)enc_fwd, hipFuncAttributeMaxDynamicSharedMemorySize, LDS_BYTES) != hipSuccess) { fprintf(stderr, "kernel_launch: hipFuncSetAttribute failed\n"); grid = -1; return; }
        int per_cu = 0;
        if (hipOccupancyMaxActiveBlocksPerMultiprocessor(&per_cu, (const void*)enc_fwd, NWAVES * 64, LDS_BYTES) != hipSuccess || per_cu < 1) fprintf(stderr, "kernel_launch: occupancy query reports %d\n", per_cu);
        (void)hipGetLastError();
        grid = cus;
    }
    if (grid < 0) return;
    if (hipMemsetAsync((char*)d_ws + WS_CTL, 0, CTL_ZERO_BYTES, stream) != hipSuccess) return;
    Args a{};
    for (int i = 0; i < 17; ++i) a.in[i] = (const float*)d_in[i];
    a.out = (float*)d_out; a.ws = (unsigned char*)d_ws;
#if MK_ONE_LAUNCH
    a.ph_lo = 0; a.ph_hi = NPHASES;
    hipLaunchKernelGGL(enc_fwd, dim3(grid), dim3(NWAVES * 64), LDS_BYTES, stream, a);
#else
    for (int p = 0; p < NPHASES; ++p) { a.ph_lo = p; a.ph_hi = p + 1; hipLaunchKernelGGL(enc_fwd, dim3(grid), dim3(NWAVES * 64), LDS_BYTES, stream, a); }
#endif
}
```

```cpp
#include <hip/hip_runtime.h>
#include <cstdio>
#include <cstdint>
namespace pg8 {
#define PG8_LAS __attribute__((address_space(3)))
typedef unsigned short bf16_t;
typedef short bf16x8 __attribute__((ext_vector_type(8)));
typedef float f32x4 __attribute__((ext_vector_type(4)));
typedef unsigned u32x4 __attribute__((ext_vector_type(4)));
typedef int v4i_t __attribute__((ext_vector_type(4)));
typedef int v8i_t __attribute__((ext_vector_type(8)));
constexpr int BM = 256, BK = 64, HALF = 128, HTB = HALF * BK * 2  , STAGE_BYTES = 8 * HTB, NXCD = 8, WGM = 8;

__host__ __device__ __forceinline__ int lds_byte(int r, int c) { const int st = (r >> 4) * 2 + (c >> 5), rr = r & 15, cc = c & 31, ob = rr * 64 + cc * 2; return st * 1024 + (ob ^ (((ob >> 9) & 1) << 5)); }
__host__ __device__ __forceinline__ void stage_rc(int b, int& R, int& C) { const int st = b / 1024, sb = b % 1024, swz = sb ^ (((sb >> 9) & 1) << 5); R = (st >> 1) * 16 + swz / 64; C = (st & 1) * 32 + (swz % 64) / 2; }
__host__ __device__ __forceinline__ int perm32(int rho) { const int n = rho >> 4, i = rho & 15; return 8 * (i >> 2) + 4 * n + (i & 3); }

struct Unit { int pm, pn; };
struct Gemm { const bf16_t* A; const bf16_t* Bt; int M, N, K; int sw = 0x79797979, sa = 0x7f7f7f7f; };

struct StaticOrder {
    int nM, nN, nwg, G, c;
    __host__ __device__ void init(int M, int N, int G_, int c_) { nM = M / BM; nN = N / BM; nwg = nM * nN; G = G_; c = c_; }
    __host__ __device__ bool next(int i, Unit& u) const {
        const long L = (long)i * G + c; if (L >= nwg) return false;
        int wgid = (int)L; { const int q = nwg / NXCD, r = nwg % NXCD, xcd = wgid % NXCD, off = wgid / NXCD; wgid = (xcd < r ? xcd * (q + 1) : r * (q + 1) + (xcd - r) * q) + off; }
        const int nig = WGM * nN, gid = wgid / nig, fm = gid * WGM, gsz = (nM - fm) < WGM ? (nM - fm) : WGM;
        u.pm = fm + ((wgid % nig) % gsz); u.pn = (wgid % nig) / gsz; return true;
    }
    __device__ __forceinline__ void a_ready(const Unit&) const {}
    __device__ __forceinline__ void done(const Unit&) const {}
    static constexpr bool BGATHER = false;
    __device__ __forceinline__ size_t b_off(int) const { return 0; }
    int brow_bytes = 0;
};
struct DftOrder : StaticOrder {
    static constexpr bool BGATHER = true;
    int tsh; size_t gjump;
    __device__ __forceinline__ size_t b_off(int pn) const { return (size_t)pn * 1024 + (size_t)(pn >> tsh) * gjump; }
};

typedef float cvt_f32x2 __attribute__((ext_vector_type(2))); typedef __bf16 cvt_bf16x2 __attribute__((ext_vector_type(2)));
__device__ __forceinline__ unsigned cvt_pk_bf16(float lo, float hi) { cvt_f32x2 v = {lo, hi}; cvt_bf16x2 b = __builtin_convertvector(v, cvt_bf16x2); return __builtin_bit_cast(unsigned, b); }
typedef unsigned u32x2 __attribute__((ext_vector_type(2)));
typedef float f32x2 __attribute__((ext_vector_type(2)));
__device__ __forceinline__ float bf_lo(unsigned w) { return __uint_as_float(w << 16); }
__device__ __forceinline__ float bf_hi(unsigned w) { return __uint_as_float(w & 0xffff0000u); }
__device__ __forceinline__ float sigm(float x) { return __builtin_amdgcn_rcpf(1.0f + __expf(-x)); }

struct EpiBf16S {
    static constexpr bool PERM = true, AFTER_DRAIN = false;
    bf16_t* O; int ldc; float scale;
    __device__ __forceinline__ void operator()(const f32x4 (&acc)[2][2][4][2], const Unit& u, int wr, int wc, int fr, int fq) const {
        const int row0 = u.pm * BM + wr * 64 + fr, col0 = u.pn * BM + wc * 32 + 8 * fq;
#pragma unroll
        for (int ai = 0; ai < 2; ++ai)
#pragma unroll
            for (int m = 0; m < 4; ++m) { bf16_t* rowp = O + (size_t)(row0 + ai * HALF + m * 16) * ldc + col0;
#pragma unroll
                for (int bj = 0; bj < 2; ++bj) { const f32x4 v0 = acc[ai][bj][m][0] * scale, v1 = acc[ai][bj][m][1] * scale;
                    u32x4 w; w.x = cvt_pk_bf16(v0[0], v0[1]); w.y = cvt_pk_bf16(v0[2], v0[3]); w.z = cvt_pk_bf16(v1[0], v1[1]); w.w = cvt_pk_bf16(v1[2], v1[3]);
                    *(u32x4*)(rowp + bj * HALF) = w; } }
    }
};
struct EpiFour {
    static constexpr bool PERM = true, AFTER_DRAIN = false;
    bf16_t* FO; int seq_off, nkb; float scale;
    __device__ __forceinline__ void operator()(const f32x4 (&acc)[2][2][4][2], const Unit& u, int wr, int wc, int fr, int fq) const {
        const int row0 = u.pm * BM + wr * 64 + fr, kb0 = wc * 32 + 8 * fq;
        if (kb0 >= nkb) return;
#pragma unroll
        for (int ai = 0; ai < 2; ++ai)
#pragma unroll
            for (int m = 0; m < 4; ++m) { const int row = row0 + ai * HALF + m * 16, cp = row & 255, gk = row >> 8, ka = gk & 127, g = gk >> 7;
                bf16_t* p = FO + (size_t)(seq_off + ka + 128 * kb0) * 1024 + g * 256 + cp;
#pragma unroll
                for (int n = 0; n < 2; ++n)
#pragma unroll
                    for (int j = 0; j < 4; ++j) { const unsigned w = cvt_pk_bf16(acc[ai][0][m][n][j] * scale, 0.f); p[(size_t)(128 * (4 * n + j)) * 1024] = (bf16_t)(w & 0xffffu); } }
    }
};
struct EpiTwT {
    static constexpr bool PERM = true, AFTER_DRAIN = false;
    bf16_t* A2; float scale; const float* tw;
    __device__ __forceinline__ void operator()(const f32x4 (&acc)[2][2][4][2], const Unit& u, int wr, int wc, int fr, int fq) const {
        const bool smp = u.pn >= 512; const int nsh = smp ? 6 : 7, tsh = smp ? 1 : 0  , Sm1 = smp ? 8191 : 16383; const int roff = smp ? 131072 : 0;
#pragma unroll
        for (int m = 0; m < 4; ++m) { const int ka = wr * 64 + m * 16 + fr;
            const f32x2 st_ = *(const f32x2*)(tw + 2 * (ka << tsh)); const float scs = st_[0], ssn = st_[1];
#pragma unroll
            for (int bj = 0; bj < 2; ++bj) { const int rho = u.pn * BM + bj * HALF + wc * 32 + 8 * fq - roff, slo = rho & ((1 << nsh) - 1), cg = rho >> nsh, g = cg & 3, cp = cg >> 2;
                const f32x2 t0_ = *(const f32x2*)(tw + 2 * (((ka * slo) & Sm1) << tsh));
                bf16_t* p = A2 + ((size_t)roff + (size_t)((g * 128 + ka) * 256 + cp)) * 256 + slo;
#pragma unroll
                for (int ri = 0; ri < 2; ++ri) { float cs = t0_[0], sn = t0_[1]; float o_[8];
#pragma unroll
                    for (int n = 0; n < 2; ++n)
#pragma unroll
                        for (int j = 0; j < 4; ++j) { const float yr = acc[0][bj][m][n][j] * scale, yi = acc[1][bj][m][n][j] * scale; o_[4 * n + j] = ri ? yi * cs - yr * sn : yr * cs + yi * sn;
                            const float c2 = cs * scs - sn * ssn; sn = sn * scs + cs * ssn; cs = c2; }
                    u32x4 w; w.x = cvt_pk_bf16(o_[0], o_[1]); w.y = cvt_pk_bf16(o_[2], o_[3]); w.z = cvt_pk_bf16(o_[4], o_[5]); w.w = cvt_pk_bf16(o_[6], o_[7]); *(u32x4*)(p + 128 * ri) = w; }
                if (smp) { const u32x4 z = {0u, 0u, 0u, 0u}; *(u32x4*)(p + 64) = z; *(u32x4*)(p + 192) = z; } }
            asm volatile("" ::: "memory"); }
    }
};
struct EpiA1 {
    static constexpr bool PERM = true, AFTER_DRAIN = false;
    bf16_t* A1; int tsh, nsh; float scale;
    __device__ __forceinline__ void operator()(const f32x4 (&acc)[2][2][4][2], const Unit& u, int wr, int wc, int fr, int fq) const {
        const int g = u.pn >> tsh, t = u.pn & ((1 << tsh) - 1), sh0 = wc * 32 + 8 * fq, ri = u.pm;
#pragma unroll
        for (int ai = 0; ai < 2; ++ai)
#pragma unroll
            for (int m = 0; m < 4; ++m) { const int cp = ai * HALF + wr * 64 + m * 16 + fr;
#pragma unroll
                for (int bj = 0; bj < 2; ++bj) { const int slo = 2 * t + bj; const f32x4 v0 = acc[ai][bj][m][0] * scale, v1 = acc[ai][bj][m][1] * scale;
                    u32x4 w; w.x = cvt_pk_bf16(v0[0], v0[1]); w.y = cvt_pk_bf16(v0[2], v0[3]); w.z = cvt_pk_bf16(v1[0], v1[1]); w.w = cvt_pk_bf16(v1[2], v1[3]);
                    *(u32x4*)(A1 + (size_t)((((cp * 4 + g) << nsh) + slo)) * 256 + ri * 128 + sh0) = w; } }
    }
};
__device__ __forceinline__ void pair_store_bf16(bf16_t* rowp_even  , size_t row_stride, const u32x4& x0, const u32x4& x1, bool odd) {
    u32x4 s_, r_, d1, d2;
#pragma unroll
    for (int k = 0; k < 4; ++k) { s_[k] = odd ? x0[k] : x1[k]; r_[k] = (unsigned)__builtin_amdgcn_mov_dpp((int)s_[k], 0xB1, 0xF, 0xF, true); d1[k] = odd ? r_[k] : x0[k]; d2[k] = odd ? x1[k] : r_[k]; }
    *(u32x4*)rowp_even = d1; *(u32x4*)(rowp_even + row_stride) = d2;
}
struct EpiQKVF {
    static constexpr bool PERM = true, AFTER_DRAIN = false;
    bf16_t *Q, *Kb, *V, *F; const float* rope; int pn_off;
    __device__ __forceinline__ void operator()(const f32x4 (&acc)[2][2][4][2], const Unit& u, int wr, int wc, int fr, int fq) const {
        const int row0 = u.pm * BM + wr * 64 + fr; const int pn = u.pn + pn_off;
        if (pn < 24) {
            bf16_t* base = pn < 12 ? Q : Kb; const int hp = pn < 12 ? pn : pn - 12;
            const int seq_off = u.pm >= 64 ? 16384 : 0;
            const float qs = pn < 12 ? 0.08838834764831845f * 1.4426950408889634f : 1.0f;
            const int head = 2 * hp + (wc >> 1), d0 = 32 * (wc & 1) + 8 * fq;
#pragma unroll
            for (int ai = 0; ai < 2; ++ai)
#pragma unroll
                for (int m = 0; m < 4; ++m) { const int row = row0 + ai * HALF + m * 16; const int pos = row - seq_off;
                    const u32x4* rp = (const u32x4*)((const unsigned*)rope + ((size_t)pos * 64 + d0));
                    u32x4 wa, wb;
#pragma unroll
                    for (int bj = 0; bj < 2; ++bj) { const u32x4 rr = rp[bj];
                        const float cs[4] = {bf_lo(rr[0]), bf_lo(rr[1]), bf_lo(rr[2]), bf_lo(rr[3])}, sn[4] = {bf_hi(rr[0]), bf_hi(rr[1]), bf_hi(rr[2]), bf_hi(rr[3])};
                        const f32x4 t1 = acc[ai][bj][m][0], t2 = acc[ai][bj][m][1]; float o1[4], o2[4];
#pragma unroll
                        for (int j = 0; j < 4; ++j) { o1[j] = (t1[j] * cs[j] - t2[j] * sn[j]) * qs; o2[j] = (t2[j] * cs[j] + t1[j] * sn[j]) * qs; }
                        wa[2 * bj] = cvt_pk_bf16(o1[0], o1[1]); wa[2 * bj + 1] = cvt_pk_bf16(o1[2], o1[3]); wb[2 * bj] = cvt_pk_bf16(o2[0], o2[1]); wb[2 * bj + 1] = cvt_pk_bf16(o2[2], o2[3]); }
                    const bool odd = fr & 1;
                    pair_store_bf16(base + (size_t)(row - (odd ? 1 : 0)) * 3072 + head * 128 + 64 * (wc & 1) + 8 * fq + (odd ? 32 : 0), 3072, wa, wb, odd); }
        } else {
            if (pn < 36) {
                unsigned char* vb = (unsigned char*)V + (size_t)((pn - 24) * 256 + wc * 64 + 16 * fq);
#pragma unroll
                for (int ai = 0; ai < 2; ++ai)
#pragma unroll
                    for (int m = 0; m < 4; ++m) { unsigned char* rowp = vb + (size_t)(row0 + ai * HALF + m * 16) * 3072; u32x4 w;
#pragma unroll
                        for (int bj = 0; bj < 2; ++bj) { const f32x4 v0 = acc[ai][bj][m][0] * 16.f, v1 = acc[ai][bj][m][1] * 16.f; int t = 0;
                            t = __builtin_amdgcn_cvt_pk_fp8_f32(v0[0], v0[1], t, false); t = __builtin_amdgcn_cvt_pk_fp8_f32(v0[2], v0[3], t, true); w[2 * bj] = (unsigned)t; t = 0;
                            t = __builtin_amdgcn_cvt_pk_fp8_f32(v1[0], v1[1], t, false); t = __builtin_amdgcn_cvt_pk_fp8_f32(v1[2], v1[3], t, true); w[2 * bj + 1] = (unsigned)t; }
                        *(u32x4*)rowp = w; }
                return; }
            bf16_t* base = F + (size_t)(pn - 36) * 24576 * 256; const bool odd = fr & 1;
#pragma unroll
            for (int ai = 0; ai < 2; ++ai)
#pragma unroll
                for (int m = 0; m < 4; ++m) { u32x4 w[2];
#pragma unroll
                    for (int bj = 0; bj < 2; ++bj) { const f32x4 v0 = acc[ai][bj][m][0], v1 = acc[ai][bj][m][1];
                        w[bj].x = cvt_pk_bf16(v0[0], v0[1]); w[bj].y = cvt_pk_bf16(v0[2], v0[3]); w[bj].z = cvt_pk_bf16(v1[0], v1[1]); w[bj].w = cvt_pk_bf16(v1[2], v1[3]); }
                    pair_store_bf16(base + (size_t)(row0 + ai * HALF + m * 16 - (odd ? 1 : 0)) * 256 + wc * 64 + 16 * fq + (odd ? 8 : 0), 256, w[0], w[1], odd); }
        }
    }
};
__device__ __forceinline__ size_t pr_off(size_t row, int col, int width) { return (row >> 1) * (size_t)(2 * width) + (size_t)((col & ~63) << 1) + ((row & 1) << 6) + (col & 63); }
struct EpiGates {
    static constexpr bool PERM = true, AFTER_DRAIN = false;
    unsigned char* G;
    static __device__ __forceinline__ unsigned q8x4(const f32x4 v) {
        const f32x4 e = {__builtin_amdgcn_exp2f(-v[0]), __builtin_amdgcn_exp2f(-v[1]), __builtin_amdgcn_exp2f(-v[2]), __builtin_amdgcn_exp2f(-v[3])}; const f32x4 den = e + 1.0f;
        const f32x4 r = {__builtin_amdgcn_rcpf(den[0]), __builtin_amdgcn_rcpf(den[1]), __builtin_amdgcn_rcpf(den[2]), __builtin_amdgcn_rcpf(den[3])}; const f32x4 q = r * 256.f + 0.5f;
        return (unsigned)fminf(q[0], 255.5f) | ((unsigned)fminf(q[1], 255.5f) << 8) | ((unsigned)fminf(q[2], 255.5f) << 16) | ((unsigned)fminf(q[3], 255.5f) << 24); }
    __device__ __forceinline__ void operator()(const f32x4 (&acc)[2][2][4][2], const Unit& u, int wr, int wc, int fr, int fq) const {
        const int row0 = u.pm * BM + wr * 64 + fr, col0 = u.pn * BM + wc * 64 + 16 * fq;
#pragma unroll
        for (int ai = 0; ai < 2; ++ai)
#pragma unroll
            for (int m = 0; m < 4; ++m) { unsigned char* rowp = G + pr_off((size_t)(row0 + ai * HALF + m * 16), col0, 8192); u32x4 w;
#pragma unroll
                for (int bj = 0; bj < 2; ++bj) { const f32x4 v0 = acc[ai][bj][m][0], v1 = acc[ai][bj][m][1];
                    w[2 * bj] = q8x4(v0); w[2 * bj + 1] = q8x4(v1); }
                *(u32x4*)rowp = w; }
    }
};
template <int MODE> struct EpiBranch {
    static constexpr bool PERM = true, AFTER_DRAIN = false;
    const unsigned char* G; bf16_t* Mg; unsigned char* Ma;
    static __device__ __forceinline__ float ub(unsigned w, int k) { return (float)((w >> (8 * k)) & 255u); }
    __device__ __forceinline__ void operator()(const f32x4 (&acc)[2][2][4][2], const Unit& u, int wr, int wc, int fr, int fq) const {
        const int row0 = u.pm * BM + wr * 64 + fr;
        if constexpr (MODE == 0) {
            const int col0 = u.pn * BM + wc * 64 + 16 * fq;
#pragma unroll
            for (int ai = 0; ai < 2; ++ai)
#pragma unroll
                for (int m = 0; m < 4; ++m) { const size_t row = (size_t)(row0 + ai * HALF + m * 16);
                    const u32x4 g = *(const u32x4*)(G + pr_off(row, col0, 8192)); u32x4 w;
#pragma unroll
                    for (int bj = 0; bj < 2; ++bj) { const f32x4 v0 = acc[ai][bj][m][0], v1 = acc[ai][bj][m][1]; const unsigned g0 = g[2 * bj], g1 = g[2 * bj + 1]; int t = 0;
                        t = __builtin_amdgcn_cvt_pk_fp8_f32(ub(g0, 0) * v0[0], ub(g0, 1) * v0[1], t, false); t = __builtin_amdgcn_cvt_pk_fp8_f32(ub(g0, 2) * v0[2], ub(g0, 3) * v0[3], t, true); w[2 * bj] = (unsigned)t; t = 0;
                        t = __builtin_amdgcn_cvt_pk_fp8_f32(ub(g1, 0) * v1[0], ub(g1, 1) * v1[1], t, false); t = __builtin_amdgcn_cvt_pk_fp8_f32(ub(g1, 2) * v1[2], ub(g1, 3) * v1[3], t, true); w[2 * bj + 1] = (unsigned)t; }
                    *(u32x4*)(Ma + pr_off(row, col0, 4096)) = w; }
        } else {
            const int col0 = u.pn * BM + wc * 64 + 16 * fq; const bool odd = fr & 1;
#pragma unroll
            for (int ai = 0; ai < 2; ++ai)
#pragma unroll
                for (int m = 0; m < 4; ++m) { const size_t row = (size_t)(row0 + ai * HALF + m * 16);
                    const u32x4 g4 = *(const u32x4*)(G + pr_off(row, 4096 + col0, 8192)), p4 = *(const u32x4*)(Ma + pr_off(row, col0, 4096)); u32x4 w[2];
#pragma unroll
                    for (int bj = 0; bj < 2; ++bj) { const f32x4 v0 = acc[ai][bj][m][0], v1 = acc[ai][bj][m][1];
                        const unsigned gx = g4[2 * bj], gy = g4[2 * bj + 1], px = p4[2 * bj], py = p4[2 * bj + 1];
                        float o[8] = {ub(gx, 0) * v0[0], ub(gx, 1) * v0[1], ub(gx, 2) * v0[2], ub(gx, 3) * v0[3], ub(gy, 0) * v1[0], ub(gy, 1) * v1[1], ub(gy, 2) * v1[2], ub(gy, 3) * v1[3]};
                        const cvt_f32x2 p0 = __builtin_amdgcn_cvt_pk_f32_fp8((int)px, false), p1 = __builtin_amdgcn_cvt_pk_f32_fp8((int)px, true), p2 = __builtin_amdgcn_cvt_pk_f32_fp8((int)py, false), p3 = __builtin_amdgcn_cvt_pk_f32_fp8((int)py, true);
                        o[0] += 0.015625f * p0[0]; o[1] += 0.015625f * p0[1]; o[2] += 0.015625f * p1[0]; o[3] += 0.015625f * p1[1]; o[4] += 0.015625f * p2[0]; o[5] += 0.015625f * p2[1]; o[6] += 0.015625f * p3[0]; o[7] += 0.015625f * p3[1];
                        w[bj].x = cvt_pk_bf16(o[0], o[1]); w[bj].y = cvt_pk_bf16(o[2], o[3]); w[bj].z = cvt_pk_bf16(o[4], o[5]); w[bj].w = cvt_pk_bf16(o[6], o[7]); }
                    pair_store_bf16(Mg + (row - (odd ? 1 : 0)) * 4096 + col0 + (odd ? 8 : 0), 4096, w[0], w[1], odd); }
        }
    }
};
struct EpiResid {
    static constexpr bool PERM = false, AFTER_DRAIN = false;
    const float* base0; const float* base1; float* out; const float* gate0; const float* gate1; float alpha;
    __device__ __forceinline__ void operator()(const f32x4 (&acc)[2][2][4][2], const Unit& u, int wr, int wc, int fr, int fq) const {
        const int row0 = u.pm * BM + wr * 64 + fr, col0 = u.pn * BM + wc * 32 + 4 * fq;
        const bool smp = u.pm >= 64; const float* gate = smp ? gate1 : gate0; const float* bs = smp ? base1 - (size_t)16384 * 4096 : base0;
        f32x4 gv[2][2];
#pragma unroll
        for (int bj = 0; bj < 2; ++bj)
#pragma unroll
            for (int n = 0; n < 2; ++n) gv[bj][n] = *(const f32x4*)(gate + col0 + bj * HALF + n * 16);
#pragma unroll
        for (int ai = 0; ai < 2; ++ai)
#pragma unroll
            for (int m = 0; m < 4; ++m) { const size_t off = (size_t)(row0 + ai * HALF + m * 16) * 4096 + col0;
#pragma unroll
                for (int bj = 0; bj < 2; ++bj)
#pragma unroll
                    for (int n = 0; n < 2; ++n) { const f32x4 b = *(const f32x4*)(bs + off + bj * HALF + n * 16);
                        *(f32x4*)(out + off + bj * HALF + n * 16) = b * alpha + gv[bj][n] * acc[ai][bj][m][n]; } }
    }
};
struct EpiContrib {
    static constexpr bool PERM = true, AFTER_DRAIN = false;
    bf16_t* C; const float* gate0; const float* gate1;
    __device__ __forceinline__ void operator()(const f32x4 (&acc)[2][2][4][2], const Unit& u, int wr, int wc, int fr, int fq) const {
        const int row0 = u.pm * BM + wr * 64 + fr, col0 = u.pn * BM + wc * 64 + 16 * fq;
        const float* gate = u.pm >= 64 ? gate1 : gate0; const bool odd = fr & 1;
        f32x4 gv[2][2];
#pragma unroll
        for (int bj = 0; bj < 2; ++bj)
#pragma unroll
            for (int n = 0; n < 2; ++n) gv[bj][n] = *(const f32x4*)(gate + col0 + bj * 8 + 4 * n);
#pragma unroll
        for (int ai = 0; ai < 2; ++ai)
#pragma unroll
            for (int m = 0; m < 4; ++m) { u32x4 w[2];
#pragma unroll
                for (int bj = 0; bj < 2; ++bj) { const f32x4 v0 = acc[ai][bj][m][0] * gv[bj][0], v1 = acc[ai][bj][m][1] * gv[bj][1];
                    w[bj].x = cvt_pk_bf16(v0[0], v0[1]); w[bj].y = cvt_pk_bf16(v0[2], v0[3]); w[bj].z = cvt_pk_bf16(v1[0], v1[1]); w[bj].w = cvt_pk_bf16(v1[2], v1[3]); }
                pair_store_bf16(C + (size_t)(row0 + ai * HALF + m * 16 - (odd ? 1 : 0)) * 4096 + col0 + (odd ? 8 : 0), 4096, w[0], w[1], odd); }
    }
};
constexpr float LOG2E_16 = 1.4426950408889634f / 16.0f;
struct EpiGU {
    static constexpr bool PERM = true, AFTER_DRAIN = false;
    unsigned char* Hd;
    __device__ __forceinline__ void operator()(const f32x4 (&acc)[2][2][4][2], const Unit& u, int wr, int wc, int fr, int fq) const {
        const int row0 = u.pm * BM + wr * 64 + fr, col0 = u.pn * 128 + wc * 32 + 8 * fq;
#pragma unroll
        for (int ai = 0; ai < 2; ++ai)
#pragma unroll
            for (int m = 0; m < 4; ++m) { unsigned char* rowp = Hd + (size_t)(row0 + ai * HALF + m * 16) * 11008 + col0; u32x2 w2;
#pragma unroll
                for (int bj = 0; bj < 2; ++bj) { const f32x4 g = acc[ai][bj][m][0], up = acc[ai][bj][m][1];
                    const f32x4 e = {__builtin_amdgcn_exp2f(-g[0]), __builtin_amdgcn_exp2f(-g[1]), __builtin_amdgcn_exp2f(-g[2]), __builtin_amdgcn_exp2f(-g[3])};
                    const f32x4 den = e * LOG2E_16 + LOG2E_16;
                    const f32x4 rc = {__builtin_amdgcn_rcpf(den[0]), __builtin_amdgcn_rcpf(den[1]), __builtin_amdgcn_rcpf(den[2]), __builtin_amdgcn_rcpf(den[3])};
                    const f32x4 o = (g * up) * rc;
                    int w = 0; w = __builtin_amdgcn_cvt_pk_fp8_f32(o[0], o[1], w, false); w = __builtin_amdgcn_cvt_pk_fp8_f32(o[2], o[3], w, true);
                    w2[bj] = (unsigned)w; }
                *(u32x2*)rowp = w2; }
    }
};
template <class Epi, class Sched, bool ALIGN_EPI = false, bool SP2 = false, bool FP8 = false>
__device__ __forceinline__ void gemm_phase(PG8_LAS unsigned char* lds, const Gemm g, const Sched& S, const Epi& E, int tid_in) {
    int tid_ = tid_in; asm volatile("" : "+v"(tid_));
    const int tid = tid_, wid = __builtin_amdgcn_readfirstlane(tid >> 6), lane = tid & 63, wr = wid >> 2, wc = wid & 3, fr = lane & 15, fq = lane >> 4;
    const int K = g.K, RB = FP8 ? K : 2 * K  , nt = RB / (BK * 2);
    unsigned voffA[2], voffB[2];
#pragma unroll
    for (int i = 0; i < 2; ++i) { int R, C; stage_rc(tid * 16 + i * 8192, R, C); const int Rb = Epi::PERM ? ((R & ~31) + perm32(R & 31)) : R;
        voffA[i] = (unsigned)(R * RB + C * 2); voffB[i] = (unsigned)(Rb * (Sched::BGATHER ? S.brow_bytes : RB) + C * 2); }
    const size_t kstep = (size_t)(BK * 2);
    const size_t hstep = (size_t)HALF * RB;
    const size_t tstep = 2 * hstep;
    const size_t hstepB = Sched::BGATHER ? (size_t)512 : hstep;
    const unsigned ldsw = (unsigned)wid * 1024u;
    const int aoff = lds_byte(wr * 64 + fr, fq * 8), boff = lds_byte(wc * 32 + fr, fq * 8);
#define PG8_SA(b, h) (((b) * 2 + (h)) * HTB)
#define PG8_SB(b, h) ((4 + (b) * 2 + (h)) * HTB)
#define PG8_STAGE(bufoff, gbase, voff) do { _Pragma("unroll") for (int _i = 0; _i < 2; ++_i) \
        __builtin_amdgcn_global_load_lds((const unsigned*)((const char*)(gbase) + (voff)[_i]), (PG8_LAS unsigned*)(lds + (bufoff) + ldsw + _i * 8192), 16, 0, 0); } while (0)
#define PG8_LDA(dst, b, h) do { if constexpr (FP8) { _Pragma("unroll") for (int m = 0; m < 4; ++m) { const v4i_t lo_ = *(const PG8_LAS v4i_t*)(lds + PG8_SA(b, h) + aoff + m * 2048), hi_ = *(const PG8_LAS v4i_t*)(lds + PG8_SA(b, h) + aoff + m * 2048 + 1024); dst##8[m] = __builtin_shufflevector(lo_, hi_, 0, 1, 2, 3, 4, 5, 6, 7); } } \
      else { _Pragma("unroll") for (int m = 0; m < 4; ++m) _Pragma("unroll") for (int k = 0; k < 2; ++k) dst[m][k] = *(const PG8_LAS bf16x8*)(lds + PG8_SA(b, h) + aoff + m * 2048 + k * 1024); } } while (0)
#define PG8_LDB(dst, b, h) do { if constexpr (FP8) { _Pragma("unroll") for (int n = 0; n < 2; ++n) { const v4i_t lo_ = *(const PG8_LAS v4i_t*)(lds + PG8_SB(b, h) + boff + n * 2048), hi_ = *(const PG8_LAS v4i_t*)(lds + PG8_SB(b, h) + boff + n * 2048 + 1024); dst##8[n] = __builtin_shufflevector(lo_, hi_, 0, 1, 2, 3, 4, 5, 6, 7); } } \
      else { _Pragma("unroll") for (int n = 0; n < 2; ++n) _Pragma("unroll") for (int k = 0; k < 2; ++k) dst[n][k] = *(const PG8_LAS bf16x8*)(lds + PG8_SB(b, h) + boff + n * 2048 + k * 1024); } } while (0)
#define PG8_MMA(ai, bj, At, Bt) do { __builtin_amdgcn_s_setprio(1); if constexpr (FP8) { _Pragma("unroll") for (int m = 0; m < 4; ++m) _Pragma("unroll") for (int n = 0; n < 2; ++n) \
        asm volatile("v_mfma_scale_f32_16x16x128_f8f6f4 %0, %1, %2, %0, %3, %4 op_sel_hi:[0,0,0]" : "+v"(acc[ai][bj][m][n]) : "v"(Bt##8[n]), "v"(At##8[m]), "v"(sc_w), "v"(sc_a)); } \
      else { _Pragma("unroll") for (int m = 0; m < 4; ++m) _Pragma("unroll") for (int n = 0; n < 2; ++n) _Pragma("unroll") for (int k = 0; k < 2; ++k) \
        acc[ai][bj][m][n] = __builtin_amdgcn_mfma_f32_16x16x32_bf16(Bt[n][k], At[m][k], acc[ai][bj][m][n], 0, 0, 0); } __builtin_amdgcn_s_setprio(0); } while (0)
#define PG8_WAIT_V(n) asm volatile("s_waitcnt vmcnt(" #n ")" ::: "memory")
#define PG8_WAIT_L(n) asm volatile("s_waitcnt lgkmcnt(" #n ")" ::: "memory")
#define PG8_BAR __builtin_amdgcn_s_barrier()
#define PG8_SCHED __builtin_amdgcn_sched_barrier(0)
    Unit cur, nxt; int ui = 0;
    if (!S.next(0, cur)) return;
    f32x4 acc[2][2][4][2];
#pragma unroll
    for (int a = 0; a < 2; ++a)
#pragma unroll
        for (int b = 0; b < 2; ++b)
#pragma unroll
            for (int m = 0; m < 4; ++m)
#pragma unroll
                for (int n = 0; n < 2; ++n) acc[a][b][m][n] = (f32x4){0.f, 0.f, 0.f, 0.f};
    int sc_w = g.sw, sc_a = g.sa; asm volatile("" : "+v"(sc_w), "+v"(sc_a));
    bf16x8 At[4][2], B0[2][2], B1[2][2]; v8i_t At8[4], B08[2], B18[2];
    const char* cA = (const char*)g.A + (size_t)cur.pm * tstep; const char* cB = (const char*)g.Bt + (Sched::BGATHER ? S.b_off(cur.pn) : (size_t)cur.pn * tstep);
    S.a_ready(cur);
    if constexpr (SP2) {
        PG8_STAGE(PG8_SB(0, 0), cB, voffB); PG8_STAGE(PG8_SB(0, 1), cB + hstepB, voffB); PG8_STAGE(PG8_SA(0, 0), cA, voffA); PG8_STAGE(PG8_SA(0, 1), cA + hstep, voffA);
        if (wr == 1) PG8_BAR;
        PG8_WAIT_V(2); PG8_BAR;
        PG8_STAGE(PG8_SB(1, 0), cB + kstep, voffB); PG8_STAGE(PG8_SA(1, 0), cA + kstep, voffA); PG8_STAGE(PG8_SB(1, 1), cB + hstepB + kstep, voffB);
        PG8_WAIT_V(6); PG8_BAR;
    } else {
        PG8_STAGE(PG8_SB(0, 0), cB, voffB); PG8_STAGE(PG8_SA(0, 0), cA, voffA); PG8_STAGE(PG8_SB(0, 1), cB + hstepB, voffB); PG8_STAGE(PG8_SA(0, 1), cA + hstep, voffA);
        if (wr == 1) PG8_BAR;
        PG8_WAIT_V(4); PG8_BAR;
        PG8_STAGE(PG8_SB(1, 0), cB + kstep, voffB); PG8_STAGE(PG8_SA(1, 0), cA + kstep, voffA); PG8_STAGE(PG8_SB(1, 1), cB + hstepB + kstep, voffB);
        PG8_WAIT_V(6); PG8_BAR;
    }
    for (;;) {
        const bool has_next = S.next(ui + 1, nxt);
        const char* nA = has_next ? (const char*)g.A + (size_t)nxt.pm * tstep : cA; const char* nB = has_next ? (const char*)g.Bt + (Sched::BGATHER ? S.b_off(nxt.pn) : (size_t)nxt.pn * tstep) : cB;
        for (int t = 0; t < nt; t += 2) {
            const bool last = (t == nt - 2);
            const char* a1 = cA + (size_t)(t + 1) * kstep;
            const char* a2 = last ? nA : cA + (size_t)(t + 2) * kstep; const char* b2 = last ? nB : cB + (size_t)(t + 2) * kstep;
            const char* a3 = a2 + kstep; const char* b3 = b2 + kstep;
            if (last && has_next) S.a_ready(nxt);
            if constexpr (SP2) {
            PG8_LDB(B0, 0, 0); PG8_LDB(B1, 0, 1); PG8_SCHED; PG8_LDA(At, 0, 0); PG8_STAGE(PG8_SA(1, 1), a1 + hstep, voffA);
            PG8_WAIT_V(8); PG8_WAIT_L(0); PG8_BAR; PG8_MMA(0, 0, At, B0); PG8_MMA(0, 1, At, B1); PG8_BAR; PG8_SCHED;
            PG8_LDA(At, 0, 1); PG8_STAGE(PG8_SB(0, 0), b2, voffB); PG8_STAGE(PG8_SB(0, 1), b2 + hstepB, voffB); PG8_STAGE(PG8_SA(0, 0), a2, voffA);
            PG8_WAIT_V(8); PG8_WAIT_L(0); PG8_BAR; PG8_MMA(1, 0, At, B0); PG8_MMA(1, 1, At, B1); PG8_BAR; PG8_SCHED;
            PG8_LDB(B0, 1, 0); PG8_LDB(B1, 1, 1); PG8_SCHED; PG8_LDA(At, 1, 0); PG8_STAGE(PG8_SA(0, 1), a2 + hstep, voffA);
            PG8_WAIT_V(8); PG8_WAIT_L(0); PG8_BAR; PG8_MMA(0, 0, At, B0); PG8_MMA(0, 1, At, B1); PG8_BAR; PG8_SCHED;
            PG8_LDA(At, 1, 1); PG8_STAGE(PG8_SB(1, 0), b3, voffB); PG8_STAGE(PG8_SB(1, 1), b3 + hstepB, voffB); PG8_STAGE(PG8_SA(1, 0), a3, voffA);
            PG8_WAIT_V(8); PG8_WAIT_L(0); PG8_BAR; PG8_MMA(1, 0, At, B0); PG8_MMA(1, 1, At, B1); PG8_BAR; PG8_SCHED;
            } else {
            PG8_LDB(B0, 0, 0); PG8_SCHED; PG8_LDA(At, 0, 0); PG8_STAGE(PG8_SA(1, 1), a1 + hstep, voffA);
            PG8_WAIT_L(8); PG8_BAR; PG8_WAIT_L(0); PG8_MMA(0, 0, At, B0); PG8_BAR; PG8_SCHED;
            PG8_LDB(B1, 0, 1); PG8_STAGE(PG8_SB(0, 0), b2, voffB);
            PG8_BAR; PG8_WAIT_L(0); PG8_MMA(0, 1, At, B1); PG8_BAR;
            PG8_LDA(At, 0, 1); PG8_STAGE(PG8_SA(0, 0), a2, voffA);
            PG8_BAR; PG8_WAIT_L(0); PG8_MMA(1, 0, At, B0); PG8_BAR; PG8_SCHED;
            PG8_STAGE(PG8_SB(0, 1), b2 + hstepB, voffB);
            PG8_WAIT_V(6); PG8_BAR; PG8_MMA(1, 1, At, B1); PG8_BAR;
            PG8_LDB(B0, 1, 0); PG8_SCHED; PG8_LDA(At, 1, 0); PG8_STAGE(PG8_SA(0, 1), a2 + hstep, voffA);
            PG8_WAIT_L(8); PG8_BAR; PG8_WAIT_L(0); PG8_MMA(0, 0, At, B0); PG8_BAR; PG8_SCHED;
            PG8_LDB(B1, 1, 1); PG8_STAGE(PG8_SB(1, 0), b3, voffB);
            PG8_BAR; PG8_WAIT_L(0); PG8_MMA(0, 1, At, B1); PG8_BAR;
            PG8_LDA(At, 1, 1); PG8_STAGE(PG8_SA(1, 0), a3, voffA);
            PG8_BAR; PG8_WAIT_L(0); PG8_MMA(1, 0, At, B0); PG8_BAR; PG8_SCHED;
            PG8_STAGE(PG8_SB(1, 1), b3 + hstepB, voffB);
            PG8_WAIT_V(6); PG8_BAR; PG8_MMA(1, 1, At, B1); PG8_BAR;
            }
        }
        if constexpr (ALIGN_EPI) { if (wr == 0) PG8_BAR; }
        if constexpr (FP8) asm volatile("s_nop 15\n\ts_nop 15" ::: "memory");
        if constexpr (!Epi::AFTER_DRAIN) { E(acc, cur, wr, wc, fr, fq); S.done(cur); }
        if (!has_next) break;
#pragma unroll
        for (int a = 0; a < 2; ++a)
#pragma unroll
            for (int b = 0; b < 2; ++b)
#pragma unroll
                for (int m = 0; m < 4; ++m)
#pragma unroll
                    for (int n = 0; n < 2; ++n) acc[a][b][m][n] = (f32x4){0.f, 0.f, 0.f, 0.f};
        cur = nxt; cA = nA; cB = nB; ++ui;
        if constexpr (ALIGN_EPI) { if (wr == 1) PG8_BAR; }
    }
    PG8_WAIT_V(0);
    if constexpr (!ALIGN_EPI) { if (wr == 0) PG8_BAR; }
    PG8_BAR;
    if constexpr (Epi::AFTER_DRAIN) { E.fused(acc, cur, wr, wc, fr, fq, lds, wid, lane); S.done(cur); }
#undef PG8_SA
#undef PG8_SB
#undef PG8_STAGE
#undef PG8_LDA
#undef PG8_LDB
#undef PG8_MMA
#undef PG8_WAIT_V
#undef PG8_WAIT_L
#undef PG8_BAR
#undef PG8_SCHED
}
}

constexpr int S0 = 16384, S1 = 8192, M = S0 + S1, D = 4096, AW = 3072, NQKVF = 10240, NGATE = 8192, FF = 11008, NGU = 2 * FF, INW = 18432;
constexpr float LN_EPS = 1e-5f;
constexpr float ALPHA = 1.189207115002721f;
constexpr int NWAVES = 8;
#ifndef MK_ONE_LAUNCH
#define MK_ONE_LAUNCH 1
#endif
constexpr int NPHASES = 16;

constexpr size_t MiB = 1u << 20;
constexpr size_t WS_CTL = 0, CTL_ZERO_BYTES = 64 * 1024;
constexpr size_t WS_MODP = 1 * MiB;
constexpr size_t WS_MOD = 13 * MiB;
constexpr size_t WS_ROPE = 14 * MiB;
constexpr size_t WS_C256 = 22 * MiB;
constexpr size_t WS_D128 = WS_C256 + 256 * 1024;
constexpr size_t WS_D64 = WS_D128 + 128 * 1024;
constexpr size_t WS_TW = WS_D64 + 128 * 1024;
constexpr size_t WS_LSE = 24 * MiB;
constexpr size_t WS_W8 = 32 * MiB;
constexpr size_t WS_WF = 100 * MiB;
constexpr size_t WS_H8 = 1338 * MiB;
constexpr size_t WS_WAU = 176 * MiB;
constexpr size_t WS_WFU = 184 * MiB;
constexpr size_t WS_WMIX = 192 * MiB;
constexpr size_t WS_WGU = 224 * MiB;
constexpr size_t WS_WD = 396 * MiB;
constexpr size_t WS_H = 482 * MiB;
constexpr size_t WS_Q = 674 * MiB, WS_K = 818 * MiB, WS_V = 962 * MiB, WS_F = 1106 * MiB;
constexpr size_t WS_G = 674 * MiB;
constexpr size_t WS_HID = 674 * MiB;
constexpr size_t WS_C1 = 674 * MiB;
constexpr size_t WS_C2 = 962 * MiB;
constexpr size_t WS_OG = 1194 * MiB;
constexpr size_t WS_MA = 866 * MiB;
constexpr size_t WS_X1H = 1194 * MiB;
constexpr size_t WS_END = 1434 * MiB;
static_assert(WS_G + (size_t)24576 * 8192 <= WS_MA && WS_MA + (size_t)24576 * 4096 <= WS_OG, "ws map ma");
static_assert(WS_X1H + (size_t)24576 * 4096 * 2 <= WS_END, "ws map x1h");
static_assert(WS_W8 + (size_t)17408 * D <= WS_WF && WS_WF + (size_t)1024 * D * 2 <= WS_WAU && WS_WGU + (size_t)NGU * D * 2 <= WS_WD && WS_WD + (size_t)D * FF * 2 <= WS_H && WS_H + (size_t)M * D * 2 <= WS_Q, "ws map 1");
static_assert(WS_F + (size_t)4 * M * 256 * 2 <= WS_OG && WS_HID + (size_t)M * FF * 2 <= WS_OG && WS_G + (size_t)M * NGATE * 2 <= WS_F && WS_OG + (size_t)M * AW * 2 <= WS_H8 && WS_H8 + (size_t)M * D <= WS_END, "ws map 2");
constexpr size_t DO_Z = 0, DO_A1 = 96 * MiB, DO_A2 = 192 * MiB, DO_FOUR = 0, DO_ATTN = 336 * MiB;
constexpr int CW_BAR = 4096;

constexpr int RING_OFF = 0, RING_BYTES = 131072;
constexpr int LDSCTL_OFF = RING_BYTES, MISC_OFF = LDSCTL_OFF + 320;
constexpr int LDS_BYTES = 147456;

#define GAS __attribute__((address_space(1)))
#define LAS __attribute__((address_space(3)))
typedef unsigned short bf16;
typedef unsigned v4u __attribute__((ext_vector_type(4)));
typedef unsigned v2u __attribute__((ext_vector_type(2)));
typedef float f32x4 __attribute__((ext_vector_type(4)));
typedef short bf16x8 __attribute__((ext_vector_type(8)));
typedef GAS unsigned gu32;
#define RLX_AGENT __ATOMIC_RELAXED, __HIP_MEMORY_SCOPE_AGENT
#define LDS_WAIT() asm volatile("s_waitcnt lgkmcnt(0)" ::: "memory")
__device__ __forceinline__ unsigned f2bf(float f) { unsigned u = __builtin_bit_cast(unsigned, f); return (u + 0x7fffu + ((u >> 16) & 1u)) >> 16; }
__device__ __forceinline__ unsigned pk2(float lo, float hi) { return f2bf(lo) | (f2bf(hi) << 16); }
__device__ __forceinline__ float bfl(unsigned w) { return __uint_as_float(w << 16); }
__device__ __forceinline__ float bfh(unsigned w) { return __uint_as_float(w & 0xffff0000u); }
#define XB_TMO      128
#define XB_XCNT(j)  (256  + 64 * (j))
#define XB_XSUB(j)  (1280 + 64 * (j))
#define XB_XGEN(j)  (2304 + 64 * (j))
#define XB_TOP      3328
#define XB_TOPGEN   3392
#define XCD_BAR_WORDS 3456
#define XB_SPIN_CAP (1u << 18)

__device__ __forceinline__ unsigned xb_ld(unsigned* p)              { return __hip_atomic_load(p, __ATOMIC_RELAXED, __HIP_MEMORY_SCOPE_AGENT); }
__device__ __forceinline__ unsigned xb_add(unsigned* p, unsigned v) { return __hip_atomic_fetch_add(p, v, __ATOMIC_RELAXED, __HIP_MEMORY_SCOPE_AGENT); }
__device__ __forceinline__ unsigned xb_xcc_id() { return (unsigned)__builtin_amdgcn_s_getreg((3 << 11) | 20) & 0xFu; }
#define XB_SPIN(cond, bar) do { unsigned _sp = 0; while (cond) { __builtin_amdgcn_s_sleep(1); \
    if ((++_sp & 255u) == 0u) { if (xb_ld(&(bar)[XB_TMO])) break; if (_sp > XB_SPIN_CAP) { atomicAdd(&(bar)[XB_TMO], 1u); break; } } } } while (0)

struct XcdBarrier {
    unsigned* bar; unsigned x;
    volatile LAS unsigned* st;
};

__device__ __forceinline__ XcdBarrier xcd_barrier_post(unsigned* bar, volatile LAS unsigned* st, bool t0) {
    XcdBarrier b; b.bar = bar; b.x = xb_xcc_id(); b.st = st;
    if (t0) (void)xb_add(&bar[XB_XCNT(b.x)], 1u);
    return b;
}
__device__ __forceinline__ void xcd_barrier_complete(unsigned* bar, unsigned x, unsigned& nloc, unsigned& nx) {
    const unsigned G = gridDim.x * gridDim.y * gridDim.z;
    unsigned sum, cnt, mine, sp = 0u;
    for (;;) {
        sum = 0u; cnt = 0u; mine = 0u;
#pragma unroll
        for (unsigned j = 0; j < 16; ++j) { const unsigned c = xb_ld(&bar[XB_XCNT(j)]); sum += c; cnt += (c > 0u) ? 1u : 0u; mine = (j == x) ? c : mine; }
        if (sum == G) break;
        __builtin_amdgcn_s_sleep(1);
        if ((++sp & 255u) == 0u) { if (xb_ld(&bar[XB_TMO])) break; if (sp > XB_SPIN_CAP) { atomicAdd(&bar[XB_TMO], 1u); break; } }
    }
    nloc = mine > 0u ? mine : 1u; nx = cnt > 0u ? cnt : 1u;
}

__device__ __forceinline__ void xcd_barrier(const XcdBarrier& b, bool t0) {
    asm volatile("s_waitcnt vmcnt(0)" ::: "memory");
    __syncthreads();
    if (t0) {
        unsigned* bar = b.bar;
        __builtin_amdgcn_s_waitcnt(0);
        unsigned nloc = b.st[0], nx = b.st[1];
        if (nloc == 0u) { xcd_barrier_complete(bar, b.x, nloc, nx); b.st[0] = nloc; b.st[1] = nx; }
        const unsigned old = xb_add(&bar[XB_XSUB(b.x)], 1u);
        const unsigned gen = old / nloc;
        if (old + 1u == (gen + 1u) * nloc) {
            __builtin_amdgcn_fence(__ATOMIC_RELEASE, "agent");
            asm volatile("s_waitcnt vmcnt(0)" ::: "memory");
            const unsigned og = xb_add(&bar[XB_TOP], 1u);
            const unsigned tg = og / nx;
            if (og + 1u == (tg + 1u) * nx) xb_add(&bar[XB_TOPGEN], 1u);
            else XB_SPIN(xb_ld(&bar[XB_TOPGEN]) == tg, bar);
            __builtin_amdgcn_fence(__ATOMIC_ACQUIRE, "agent");
            xb_add(&bar[XB_XGEN(b.x)], 1u);
            asm volatile("s_waitcnt vmcnt(0)" ::: "memory");
        } else {
            XB_SPIN(xb_ld(&bar[XB_XGEN(b.x)]) == gen, bar);
            __builtin_amdgcn_fence(__ATOMIC_ACQUIRE, "agent");
            asm volatile("s_waitcnt vmcnt(0)" ::: "memory");
        }
    }
    __syncthreads();
}

struct Args { const float* in[17]; float* out; unsigned char* ws; int ph_lo, ph_hi; };
struct Frame {
    LAS unsigned char* lds;
    int tid, lane, wave, gw, NGW;
    unsigned char* ws; unsigned char* dout;
};
__device__ __forceinline__ float wave_sum(float v) {
#pragma unroll
    for (int o = 1; o < 64; o <<= 1) v += __shfl_xor(v, o);
    return v;
}
__device__ __forceinline__ void p0_mod_partials(Frame& F, const Args& A) {
    LAS float* sc = (LAS float*)(F.lds + RING_OFF);
    for (int i = F.tid; i < 2 * D; i += NWAVES * 64) { const float c = i < D ? A.in[2][i] : A.in[3][i - D]; sc[i] = c / (1.0f + expf(-c)); }
    __syncthreads();
    const float* wada = A.in[4]; float* modp = (float*)(F.ws + WS_MODP);
    for (int it = F.gw; it < 64 * 96; it += F.NGW) { const int kk = it / 96, cc = it % 96;
        const f32x4* wp = (const f32x4*)(wada + (size_t)(kk * 64) * (6 * D) + cc * 256) + F.lane;
        f32x4 a0 = {0.f, 0.f, 0.f, 0.f}, a1 = {0.f, 0.f, 0.f, 0.f};
#pragma unroll 16
        for (int k = 0; k < 64; ++k) { const f32x4 w = __builtin_nontemporal_load(wp + (size_t)k * (6 * D / 4)); const float s0 = sc[kk * 64 + k], s1 = sc[D + kk * 64 + k]; a0 += w * s0; a1 += w * s1; }
        ((f32x4*)(modp + (size_t)(kk * 2 + 0) * (6 * D) + cc * 256))[F.lane] = a0;
        ((f32x4*)(modp + (size_t)(kk * 2 + 1) * (6 * D) + cc * 256))[F.lane] = a1;
    }
    __syncthreads();
}
__device__ __forceinline__ unsigned pk4_fp8(float a, float b, float c, float d) { int w = 0; w = __builtin_amdgcn_cvt_pk_fp8_f32(a, b, w, false); w = __builtin_amdgcn_cvt_pk_fp8_f32(c, d, w, true); return (unsigned)w; }
template <int MODE> __device__ __forceinline__ int wt_row(int n) {
    if (MODE == 1) { const int d = n & 127;
        return (n & ~255) + 128 * ((d >> 2) & 1) + 32 * (2 * ((n >> 7) & 1) + ((d >> 5) & 1)) + 8 * ((d >> 3) & 3) + 4 * (d >> 6) + (d & 3); }
    if (MODE == 2 || MODE == 3) { const int c = n & 127;
        return 2 * (n & ~127) + 128 * ((c >> 2) & 1) + 32 * (c >> 5) + 8 * ((c >> 3) & 3) + (c & 3) + (MODE == 3 ? 4 : 0); }
    if (MODE == 4) { const int c = n & 255;
        return (n & ~255) + 128 * ((c >> 3) & 1) + 32 * (c >> 6) + 8 * ((c >> 4) & 3) + (c & 7); }
    return n;
}
template <int MODE> __device__ __forceinline__ void p0_transpose_item(const float* W, int K, int N, bf16* WT, int row_off, LAS float* scr, int item, int lane, float ws_ = 1.f) {
    const int nblk = N / 16, kb = item / nblk, nb = item % nblk, k0 = 128 * kb, n0 = 16 * nb;
    float ld_[32];
#pragma unroll
    for (int i = 0; i < 32; ++i) ld_[i] = W[(size_t)(k0 + 4 * i + (lane >> 4)) * N + n0 + (lane & 15)];
#pragma unroll
    for (int i = 0; i < 32; ++i) scr[(4 * i + (lane >> 4)) * 17 + (lane & 15)] = ld_[i];
    LDS_WAIT(); asm volatile("" ::: "memory");
    const int c = lane & 15;
#pragma unroll
    for (int j = 0; j < 4; ++j) { const int n = (lane >> 4) + 4 * j; const LAS float* s = scr + (8 * c) * 17 + n;
        v4u o; o.x = pk2(ws_ * s[0 * 17], ws_ * s[1 * 17]); o.y = pk2(ws_ * s[2 * 17], ws_ * s[3 * 17]); o.z = pk2(ws_ * s[4 * 17], ws_ * s[5 * 17]); o.w = pk2(ws_ * s[6 * 17], ws_ * s[7 * 17]);
        *(v4u*)(WT + (size_t)(row_off + wt_row<MODE>(n0 + n)) * K + k0 + 8 * c) = o; }
    LDS_WAIT(); asm volatile("" ::: "memory");
}
template <int MODE, bool KP = false> __device__ __forceinline__ void p0_transpose_item8(const float* W, int K, int N, unsigned char* WT, int row_off, LAS float* scr, int item, int lane, float ws_ = 64.f) {
    const int nblk = N / 16, kb = item / nblk, nb = item % nblk, k0 = 128 * kb, n0 = 16 * nb;
    float ld_[32];
#pragma unroll
    for (int i = 0; i < 32; ++i) ld_[i] = W[(size_t)(k0 + 4 * i + (lane >> 4)) * N + n0 + (lane & 15)];
#pragma unroll
    for (int i = 0; i < 32; ++i) scr[(4 * i + (lane >> 4)) * 17 + (lane & 15)] = ld_[i];
    LDS_WAIT(); asm volatile("" ::: "memory");
    const int c = lane & 15;
#pragma unroll
    for (int j = 0; j < 4; ++j) { const int n = (lane >> 4) + 4 * j; const LAS float* s = scr + (8 * c) * 17 + n;
        v2u o; o.x = pk4_fp8(ws_ * s[0 * 17], ws_ * s[1 * 17], ws_ * s[2 * 17], ws_ * s[3 * 17]); o.y = pk4_fp8(ws_ * s[4 * 17], ws_ * s[5 * 17], ws_ * s[6 * 17], ws_ * s[7 * 17]);
        unsigned char* dp = WT + (size_t)(row_off + wt_row<MODE>(n0 + n)) * K + k0;
        if constexpr (KP) { const int pos = 32 * (c >> 2) + 16 * (c & 1) + 4 * ((c >> 1) & 1);
            *(unsigned*)(dp + pos) = o.x; *(unsigned*)(dp + pos + 8) = o.y; }
        else *(v2u*)(dp + 8 * c) = o; }
    LDS_WAIT(); asm volatile("" ::: "memory");
}
template <int PART> __device__ __forceinline__ void p0_weights(Frame& F, const Args& A) {
    LAS float* scr = (LAS float*)(F.lds + RING_OFF + F.wave * 16384);
    unsigned char* w8 = F.ws + WS_W8; bf16* wf = (bf16*)(F.ws + WS_WF); bf16* wau = (bf16*)(F.ws + WS_WAU); bf16* wfu = (bf16*)(F.ws + WS_WFU); bf16* wmix = (bf16*)(F.ws + WS_WMIX); bf16* wgu = (bf16*)(F.ws + WS_WGU); bf16* wd = (bf16*)(F.ws + WS_WD);
    constexpr int I_IN = (D / 128) * (INW / 16), I_AU = (1024 / 128) * (D / 16), I_MIX = (D / 128) * (D / 16), I_G = (D / 128) * (FF / 16), I_D = (FF / 128) * (D / 16);
    constexpr int NITEMS = I_IN + 2 * I_AU + I_MIX + 2 * I_G + I_D;
    constexpr int IT_LO = PART == 0 ? 0 : NITEMS - I_D, IT_HI = PART == 0 ? NITEMS - I_D : NITEMS;
    for (int it = IT_LO + F.gw; it < IT_HI; it += F.NGW) {
        int r = it;
        if (r < I_IN) { const int nb = (r % (INW / 16)) >> 1;
            if (nb < 6144 / 32) p0_transpose_item8<1>(A.in[6], D, INW, w8, 0, scr, r, F.lane); else if (nb < 9216 / 32) p0_transpose_item8<4>(A.in[6], D, INW, w8, 0, scr, r, F.lane);
            else if (nb < 10240 / 32) p0_transpose_item<4>(A.in[6], D, INW, wf, -9216, scr, r, F.lane); else p0_transpose_item8<4>(A.in[6], D, INW, w8, -1024, scr, r, F.lane, 64.f * 1.4426950408889634f);
            continue; } r -= I_IN;
        if (r < I_AU) { p0_transpose_item8<4, true>(A.in[7], 1024, D, (unsigned char*)wau, 0, scr, r, F.lane, 32.f); continue; } r -= I_AU;
        if (r < I_AU) { p0_transpose_item<4>(A.in[8], 1024, D, wfu, 0, scr, r, F.lane, 0.00390625f);     continue; } r -= I_AU;
        if (r < I_MIX) { p0_transpose_item<4>(A.in[9], D, D, wmix, 0, scr, r, F.lane); continue; } r -= I_MIX;
        if (r < I_G) { p0_transpose_item8<2>(A.in[12], D, FF, (unsigned char*)wgu, 0, scr, r, F.lane, 64.f * 1.4426950408889634f)    ; continue; } r -= I_G;
        if (r < I_G) { p0_transpose_item8<3>(A.in[13], D, FF, (unsigned char*)wgu, 0, scr, r, F.lane, 64.f); continue; } r -= I_G;
        p0_transpose_item8<4>(A.in[14], FF, D, (unsigned char*)wd, 0, scr, r, F.lane, 128.f);
    }
}
__device__ __forceinline__ void p0_tables(Frame& F) {
    const int gt = F.gw * 64 + F.lane, NGT = F.NGW * 64;
    unsigned* rope = (unsigned*)(F.ws + WS_ROPE);
    for (int i = gt; i < S0 * 64; i += NGT) { const int pos = i >> 6, d = i & 63;
        const float inv = powf(10000.0f, -(float)d / 64.0f); const float ang = (float)pos * inv;
        const double tr = (double)ang * 0.15915494309189535; const float fr_ = (float)(tr - floor(tr));
        float sn, cs; sincospif(2.0f * fr_, &sn, &cs); rope[(size_t)i] = pk2(cs, sn); }
    { float* tw = (float*)(F.ws + WS_TW); for (int i = gt; i < S0; i += NGT) { float sn, cs; sincospif((float)i * (2.0f / (float)S0), &sn, &cs); tw[2 * i] = cs; tw[2 * i + 1] = sn; } }
    bf16* c256 = (bf16*)(F.ws + WS_C256); bf16* d128 = (bf16*)(F.ws + WS_D128); bf16* d64 = (bf16*)(F.ws + WS_D64);
    for (int i = gt; i < 512 * 256; i += NGT) { const int r = i >> 8, c = i & 255, ri = r >> 8, cp = r & 255;
        float sn, cs; sincospif((float)((c * cp) & 255) * (1.0f / 128.0f), &sn, &cs); c256[i] = (bf16)f2bf(ri ? -sn : cs); }
    for (int i = gt; i < 256 * 256; i += NGT) { const int r = i >> 8, c = i & 255, ro = r >> 7, ka = r & 127, ri = c >> 7, sh = c & 127;
        float sn, cs; sincospif((float)((ka * sh) & 127) * (1.0f / 64.0f), &sn, &cs);
        d128[i] = (bf16)f2bf(ro == ri ? cs : (ro == 0 ? sn : -sn));
        float v = 0.f; if (r < 64 && sh < 64) { float s2, c2; sincospif((float)((r * sh) & 63) * (1.0f / 32.0f), &s2, &c2); v = ri ? s2 : c2; }
        d64[i] = (bf16)f2bf(v); }
}
__device__ __forceinline__ void p1_mod_reduce(Frame& F, const Args& A) {
    const float* modp = (const float*)(F.ws + WS_MODP); float* mod = (float*)(F.ws + WS_MOD); const float* bada = A.in[5];
    for (int i = F.gw * 64 + F.lane; i < 2 * 6 * D; i += F.NGW * 64) { const int b = i / (6 * D), col = i % (6 * D); float s = bada[col];
        for (int kk = 0; kk < 64; ++kk) s += modp[(size_t)(kk * 2 + b) * (6 * D) + col];
        mod[i] = s; }
}
__device__ __forceinline__ void row_stats(const f32x4 (&v)[16], float& mean, float& rstd) {
    float s = 0.f;
#pragma unroll
    for (int j = 0; j < 16; ++j) s += (v[j][0] + v[j][1]) + (v[j][2] + v[j][3]);
    mean = wave_sum(s) * (1.0f / D); float q = 0.f;
#pragma unroll
    for (int j = 0; j < 16; ++j) { const f32x4 d = v[j] - mean; q += (d[0] * d[0] + d[1] * d[1]) + (d[2] * d[2] + d[3] * d[3]); }
    rstd = 1.0f / sqrtf(wave_sum(q) * (1.0f / D) + LN_EPS);
}
__device__ __forceinline__ void p2_ln_mod(Frame& F, const Args& A) {
    const float* mod = (const float*)(F.ws + WS_MOD); bf16* H = (bf16*)(F.ws + WS_H);
    f32x4 nx[16];
    { const int row = F.gw; const f32x4* xr = (const f32x4*)(row >= S0 ? A.in[1] + (size_t)(row - S0) * D : A.in[0] + (size_t)row * D) + F.lane;
#pragma unroll
      for (int j = 0; j < 16; ++j) nx[j] = __builtin_nontemporal_load(xr + 64 * j); }
    asm volatile("" ::: "memory");
    p0_tables(F);
    for (int row = F.gw; row < M; row += F.NGW) { const int b = row >= S0;
        const f32x4* sh = (const f32x4*)(mod + b * 6 * D) + F.lane; const f32x4* sc = (const f32x4*)(mod + b * 6 * D + D) + F.lane;
        f32x4 v[16];
#pragma unroll
        for (int j = 0; j < 16; ++j) v[j] = nx[j];
        { const int rn = row + F.NGW; if (rn < M) { const f32x4* xr = (const f32x4*)(rn >= S0 ? A.in[1] + (size_t)(rn - S0) * D : A.in[0] + (size_t)rn * D) + F.lane;
#pragma unroll
            for (int j = 0; j < 16; ++j) nx[j] = __builtin_nontemporal_load(xr + 64 * j); } }
        float mean, rstd; row_stats(v, mean, rstd);
        v2u* o = (v2u*)(H + (size_t)row * D) + F.lane; unsigned* o8 = (unsigned*)(F.ws + WS_H8 + (size_t)row * D) + F.lane;
#pragma unroll
        for (int j = 0; j < 16; ++j) { const f32x4 y = (v[j] - mean) * rstd * (sc[64 * j] + 1.0f) + sh[64 * j]; v2u w; w.x = pk2(y[0], y[1]); w.y = pk2(y[2], y[3]); o[64 * j] = w; o8[64 * j] = pk4_fp8(y[0], y[1], y[2], y[3]); }
    }
}
typedef _Float16 h16x2 __attribute__((ext_vector_type(2)));
__device__ __forceinline__ unsigned pk2_h(float a, float b) { typedef float f2_ __attribute__((ext_vector_type(2))); const h16x2 h = __builtin_convertvector((f2_){a, b}, h16x2); return __builtin_bit_cast(unsigned, h); }
__device__ __forceinline__ float hlo(unsigned w) { return (float)__builtin_bit_cast(h16x2, w)[0]; }
__device__ __forceinline__ float hhi(unsigned w) { return (float)__builtin_bit_cast(h16x2, w)[1]; }
__device__ __forceinline__ void p13_ln1(Frame& F, const Args& A) {
    const float* mod = (const float*)(F.ws + WS_MOD); bf16* H = (bf16*)(F.ws + WS_H);
    f32x4 nx[16];
    { const int row = F.gw; const f32x4* xin = (const f32x4*)(row >= S0 ? A.in[1] + (size_t)(row - S0) * D : A.in[0] + (size_t)row * D) + F.lane;
#pragma unroll
      for (int j = 0; j < 16; ++j) nx[j] = __builtin_nontemporal_load(xin + 64 * j); }
    for (int row = F.gw; row < M; row += F.NGW) { const int b = row >= S0;
        v2u* xr = (v2u*)(F.ws + WS_X1H + (size_t)row * D * 2) + F.lane;
        const v2u* c1 = (const v2u*)(F.ws + WS_C1 + (size_t)row * D * 2) + F.lane;
        const f32x4* g1 = (const f32x4*)A.in[10] + F.lane; const f32x4* b1 = (const f32x4*)A.in[11] + F.lane;
        const f32x4* sh = (const f32x4*)(mod + b * 6 * D + 3 * D) + F.lane; const f32x4* sc = (const f32x4*)(mod + b * 6 * D + 4 * D) + F.lane;
        f32x4 v[16];
#pragma unroll
        for (int j = 0; j < 16; ++j) { const v2u c = __builtin_nontemporal_load(c1 + 64 * j); v[j] = nx[j] * ALPHA + (f32x4){bfl(c.x), bfh(c.x), bfl(c.y), bfh(c.y)}; }
        { const int rn = row + F.NGW; if (rn < M) { const f32x4* xin = (const f32x4*)(rn >= S0 ? A.in[1] + (size_t)(rn - S0) * D : A.in[0] + (size_t)rn * D) + F.lane;
#pragma unroll
            for (int j = 0; j < 16; ++j) nx[j] = __builtin_nontemporal_load(xin + 64 * j); } }
        float mean, rstd; row_stats(v, mean, rstd);
#pragma unroll
        for (int j = 0; j < 16; ++j) { v[j] = (v[j] - mean) * rstd * g1[64 * j] + b1[64 * j]; v2u w; w.x = pk2_h(v[j][0], v[j][1]); w.y = pk2_h(v[j][2], v[j][3]); __builtin_nontemporal_store(w, xr + 64 * j); }
        row_stats(v, mean, rstd);
        unsigned* o8 = (unsigned*)((unsigned char*)H + (size_t)row * D) + F.lane;
#pragma unroll
        for (int j = 0; j < 16; ++j) { const f32x4 y = (v[j] - mean) * rstd * (sc[64 * j] + 1.0f) + sh[64 * j]; o8[64 * j] = pk4_fp8(y[0], y[1], y[2], y[3]); }
    }
}
__device__ __forceinline__ void p16_ln2(Frame& F, const Args& A) {
    float* out = (float*)F.dout;
    v2u nc[16], nxh[16];
    { const int row = F.gw; const v2u* c2 = (const v2u*)(F.ws + WS_C2 + (size_t)row * D * 2) + F.lane; const v2u* x1 = (const v2u*)(F.ws + WS_X1H + (size_t)row * D * 2) + F.lane;
#pragma unroll
      for (int j = 0; j < 16; ++j) { nc[j] = __builtin_nontemporal_load(c2 + 64 * j); nxh[j] = __builtin_nontemporal_load(x1 + 64 * j); } }
    for (int row = F.gw; row < M; row += F.NGW) {
        f32x4* xr = (f32x4*)(out + (size_t)row * D) + F.lane;
        const f32x4* g2 = (const f32x4*)A.in[15] + F.lane; const f32x4* b2 = (const f32x4*)A.in[16] + F.lane;
        f32x4 v[16];
#pragma unroll
        for (int j = 0; j < 16; ++j) { const v2u c = nc[j], x = nxh[j]; v[j] = (f32x4){hlo(x.x), hhi(x.x), hlo(x.y), hhi(x.y)} * ALPHA + (f32x4){bfl(c.x), bfh(c.x), bfl(c.y), bfh(c.y)}; }
        { const int rn = row + F.NGW; if (rn < M) { const v2u* c2 = (const v2u*)(F.ws + WS_C2 + (size_t)rn * D * 2) + F.lane; const v2u* x1 = (const v2u*)(F.ws + WS_X1H + (size_t)rn * D * 2) + F.lane;
#pragma unroll
            for (int j = 0; j < 16; ++j) { nc[j] = __builtin_nontemporal_load(c2 + 64 * j); nxh[j] = __builtin_nontemporal_load(x1 + 64 * j); } } }
        float mean, rstd; row_stats(v, mean, rstd);
#pragma unroll
        for (int j = 0; j < 16; ++j) __builtin_nontemporal_store((v[j] - mean) * rstd * g2[64 * j] + b2[64 * j], xr + 64 * j);
    }
}
constexpr int VT_LD = 136;
typedef short v4s_t __attribute__((ext_vector_type(4)));
__device__ __forceinline__ void attn_unit(const bf16* __restrict__ Q, const bf16* __restrict__ Kb, const unsigned char* __restrict__ V, bf16* __restrict__ OG, float* __restrict__ LSE, int unit, int lane, LAS bf16* vt) {
    const int gh = unit / 768; int u = unit - gh * 768;
    const int dsh = 2 * (gh >> 3);
    int seq_off = 0, S = S0; if (u >= 512) { u -= 512; seq_off = S0; S = S1; }
    const int L = S >> dsh, cpc = L >> 5;
    const int r = u / cpc, ch = u - r * cpc;
    const int colbase = gh * 128;
    const int i = lane & 15, h = lane >> 4;
    const int l0 = 32 * ch - 64;
    size_t qrow[2]; bf16x8 qf[2][4];
#pragma unroll
    for (int qt = 0; qt < 2; ++qt) { qrow[qt] = (size_t)seq_off + (size_t)(((32 * ch + 16 * qt + i) << dsh) + r); const bf16* qp = Q + qrow[qt] * AW + colbase + 8 * h;
#pragma unroll
        for (int ks = 0; ks < 4; ++ks) qf[qt][ks] = *(const bf16x8*)(qp + 32 * ks); }
    f32x4 sc[2][10];
    constexpr int KD = 5;
    bf16x8 kf[KD][4];
#define ATT_KLOAD(t_, dst_) do { int lk_ = l0 + 16 * (t_) + i; lk_ = lk_ < 0 ? 0 : (lk_ > L - 1 ? L - 1 : lk_); \
        const bf16* kp_ = Kb + ((size_t)seq_off + (size_t)((lk_ << dsh) + r)) * AW + colbase + 8 * h; \
        _Pragma("unroll") for (int ks = 0; ks < 4; ++ks) dst_[ks] = *(const bf16x8*)(kp_ + 32 * ks); } while (0)
#pragma unroll
    for (int t = 0; t < KD; ++t) ATT_KLOAD(t, kf[t]);
    asm volatile("" ::: "memory");
#pragma unroll
    for (int t = 0; t < 10; ++t) {
#pragma unroll
        for (int qt = 0; qt < 2; ++qt) { f32x4 a = {0.f, 0.f, 0.f, 0.f};
#pragma unroll
            for (int ks = 0; ks < 4; ++ks) a = __builtin_amdgcn_mfma_f32_16x16x32_bf16(kf[t % KD][ks], qf[qt][ks], a, 0, 0, 0);
            sc[qt][t] = a; }
        if (t + KD < 10) { ATT_KLOAD(t + KD, kf[t % KD]); asm volatile("" ::: "memory"); } }
#undef ATT_KLOAD
    v2u vv[8];
#define ATT_VLOAD(c_, dst_) do { _Pragma("unroll") for (int it = 0; it < 8; ++it) { int lk_ = l0 + 32 * (c_) + h + 4 * it; lk_ = lk_ < 0 ? 0 : (lk_ > L - 1 ? L - 1 : lk_); \
        dst_[it] = *(const v2u*)(V + ((size_t)seq_off + (size_t)((lk_ << dsh) + r)) * AW + colbase + 8 * i); } } while (0)
    ATT_VLOAD(0, vv);
    asm volatile("" ::: "memory");
    float mx[2], sum[2];
#pragma unroll
    for (int qt = 0; qt < 2; ++qt) { float m_ = -3.0e38f;
#pragma unroll
        for (int t = 0; t < 10; ++t)
#pragma unroll
            for (int rg = 0; rg < 4; ++rg) { const int c = 4 * h + rg, rel = 16 * t + c - 16 * qt - i, lk = l0 + 16 * t + c;
                const bool valid = (lk >= 0) && (lk < L) && (rel >= 0) && (rel <= 128);
                const float s_ = valid ? sc[qt][t][rg] : -1.0e30f; sc[qt][t][rg] = s_; m_ = fmaxf(m_, s_); }
        m_ = fmaxf(m_, __shfl_xor(m_, 16)); m_ = fmaxf(m_, __shfl_xor(m_, 32)); mx[qt] = m_;
        float su = 0.f;
#pragma unroll
        for (int t = 0; t < 10; ++t)
#pragma unroll
            for (int rg = 0; rg < 4; ++rg) { const float p = __builtin_amdgcn_exp2f(sc[qt][t][rg] - m_); sc[qt][t][rg] = p; su += p; }
        su += __shfl_xor(su, 16); su += __shfl_xor(su, 32); sum[qt] = su; }
    f32x4 o[2][8];
#pragma unroll
    for (int qt = 0; qt < 2; ++qt)
#pragma unroll
        for (int dc = 0; dc < 8; ++dc) o[qt][dc] = (f32x4){0.f, 0.f, 0.f, 0.f};
#pragma unroll
    for (int kk = 0; kk < 5; ++kk) {
#pragma unroll
        for (int it = 0; it < 8; ++it) { const v2u r8 = vv[it];
            const pg8::cvt_f32x2 a0 = __builtin_amdgcn_cvt_pk_f32_fp8((int)r8.x, false), a1 = __builtin_amdgcn_cvt_pk_f32_fp8((int)r8.x, true), a2 = __builtin_amdgcn_cvt_pk_f32_fp8((int)r8.y, false), a3 = __builtin_amdgcn_cvt_pk_f32_fp8((int)r8.y, true);
            v4u wv; wv.x = pk2(a0[0], a0[1]); wv.y = pk2(a1[0], a1[1]); wv.z = pk2(a2[0], a2[1]); wv.w = pk2(a3[0], a3[1]);
            *(LAS v4u*)(vt + (h + 4 * it) * VT_LD + 8 * i) = wv; }
        if (kk + 1 < 5) { ATT_VLOAD(kk + 1, vv); asm volatile("" ::: "memory"); }
        bf16x8 pf[2];
#pragma unroll
        for (int qt = 0; qt < 2; ++qt)
#pragma unroll
            for (int j = 0; j < 8; ++j) pf[qt][j] = (short)f2bf(sc[qt][2 * kk + (j >> 2)][j & 3]);
#pragma unroll
        for (int dc = 0; dc < 8; ++dc) {
            const LAS bf16* rp = vt + (4 * h + (i >> 2)) * VT_LD + 16 * dc + 4 * (i & 3);
            const v4s_t lo = __builtin_amdgcn_ds_read_tr16_b64_v4i16((LAS v4s_t*)rp), hi = __builtin_amdgcn_ds_read_tr16_b64_v4i16((LAS v4s_t*)(rp + 16 * VT_LD));
            const bf16x8 vf = __builtin_shufflevector(lo, hi, 0, 1, 2, 3, 4, 5, 6, 7);
#pragma unroll
            for (int qt = 0; qt < 2; ++qt) o[qt][dc] = __builtin_amdgcn_mfma_f32_16x16x32_bf16(vf, pf[qt], o[qt][dc], 0, 0, 0); }
    }
#undef ATT_VLOAD
#pragma unroll
    for (int qt = 0; qt < 2; ++qt) { const float inv = 0.0625f / sum[qt]; bf16* op = OG + qrow[qt] * AW + colbase + 8 * h;
#pragma unroll
        for (int s2 = 0; s2 < 4; ++s2) { v4u w; w.x = pk2(o[qt][2 * s2][0] * inv, o[qt][2 * s2][1] * inv); w.y = pk2(o[qt][2 * s2][2] * inv, o[qt][2 * s2][3] * inv);
            w.z = pk2(o[qt][2 * s2 + 1][0] * inv, o[qt][2 * s2 + 1][1] * inv); w.w = pk2(o[qt][2 * s2 + 1][2] * inv, o[qt][2 * s2 + 1][3] * inv); *(v4u*)(op + 32 * s2) = w; }
        if (h == 0) LSE[qrow[qt] * 24 + gh] = (mx[qt] + __log2f(sum[qt])) * 0.6931471805599453f; }
}
__device__ __forceinline__ void p_attention(Frame& F) {
    const bf16* Q = (const bf16*)(F.ws + WS_Q); const bf16* Kb = (const bf16*)(F.ws + WS_K); const unsigned char* V = F.ws + WS_V;
    bf16* OG = (bf16*)(F.ws + WS_OG); float* LSE = (float*)(F.ws + WS_LSE);
    LAS bf16* vt = (LAS bf16*)(F.lds + RING_OFF + F.wave * (32 * VT_LD * 2));
    for (int unit = F.gw; unit < 24 * 768; unit += F.NGW) attn_unit(Q, Kb, V, OG, LSE, unit, F.lane, vt);
    __syncthreads();
}
__device__ __forceinline__ void p_combine(Frame& F) {
    const bf16* OG = (const bf16*)(F.ws + WS_OG); const float* LSE = (const float*)(F.ws + WS_LSE); unsigned char* AT = F.dout + DO_ATTN;
    const int hh = F.lane >> 3, cq = F.lane & 7;
    v4u nv[2][3]; float nl[3];
#define PC_LOAD(row_) do { const bf16* p_ = OG + (size_t)(row_) * AW + hh * 128 + cq * 16; \
        _Pragma("unroll") for (int half = 0; half < 2; ++half) _Pragma("unroll") for (int g_ = 0; g_ < 3; ++g_) nv[half][g_] = __builtin_nontemporal_load((const v4u*)(p_ + 1024 * g_ + 8 * half)); \
        _Pragma("unroll") for (int g_ = 0; g_ < 3; ++g_) nl[g_] = LSE[(size_t)(row_) * 24 + 8 * g_ + hh]; } while (0)
    if (F.gw < M) PC_LOAD(F.gw);
    for (int row = F.gw; row < M; row += F.NGW) {
        const float l0 = nl[0], l1 = nl[1], l2 = nl[2];
        v4u cv[2][3];
#pragma unroll
        for (int half = 0; half < 2; ++half)
#pragma unroll
            for (int g_ = 0; g_ < 3; ++g_) cv[half][g_] = nv[half][g_];
        if (row + F.NGW < M) PC_LOAD(row + F.NGW);
        const float mx = fmaxf(l0, fmaxf(l1, l2)); float w0 = __expf(l0 - mx), w1 = __expf(l1 - mx), w2 = __expf(l2 - mx); const float inv = 1.0f / (w0 + w1 + w2); w0 *= inv; w1 *= inv; w2 *= inv;
        v4u o4;
#pragma unroll
        for (int half = 0; half < 2; ++half) {
            const v4u a = cv[half][0], b = cv[half][1], c = cv[half][2];
            v2u o;
            o.x = pk4_fp8(64.f * (w0 * bfl(a.x) + w1 * bfl(b.x) + w2 * bfl(c.x)), 64.f * (w0 * bfh(a.x) + w1 * bfh(b.x) + w2 * bfh(c.x)), 64.f * (w0 * bfl(a.y) + w1 * bfl(b.y) + w2 * bfl(c.y)), 64.f * (w0 * bfh(a.y) + w1 * bfh(b.y) + w2 * bfh(c.y)));
            o.y = pk4_fp8(64.f * (w0 * bfl(a.z) + w1 * bfl(b.z) + w2 * bfl(c.z)), 64.f * (w0 * bfh(a.z) + w1 * bfh(b.z) + w2 * bfh(c.z)), 64.f * (w0 * bfl(a.w) + w1 * bfl(b.w) + w2 * bfl(c.w)), 64.f * (w0 * bfh(a.w) + w1 * bfh(b.w) + w2 * bfh(c.w)));
            o4[2 * half] = o.x; o4[2 * half + 1] = o.y; }
        *(v4u*)(AT + (size_t)row * 1024 + hh * 128 + cq * 16) = o4;
    }
#undef PC_LOAD
}
__device__ __forceinline__ void tr8x8(const v4u (&in)[8], v4u (&out)[8]) {
    unsigned a[8][8];
#pragma unroll
    for (int e = 0; e < 8; ++e) { a[e][0] = in[e].x & 0xffffu; a[e][1] = in[e].x >> 16; a[e][2] = in[e].y & 0xffffu; a[e][3] = in[e].y >> 16; a[e][4] = in[e].z & 0xffffu; a[e][5] = in[e].z >> 16; a[e][6] = in[e].w & 0xffffu; a[e][7] = in[e].w >> 16; }
#pragma unroll
    for (int q = 0; q < 8; ++q) { out[q].x = a[0][q] | (a[1][q] << 16); out[q].y = a[2][q] | (a[3][q] << 16); out[q].z = a[4][q] | (a[5][q] << 16); out[q].w = a[6][q] | (a[7][q] << 16); }
}

__device__ __forceinline__ int lane_id_now() { int l; asm volatile("v_mbcnt_lo_u32_b32 %0, -1, 0\n\tv_mbcnt_hi_u32_b32 %0, -1, %0" : "=v"(l)); return l; }
__global__ void __launch_bounds__(NWAVES * 64, 2) enc_fwd(Args args) {
    extern __shared__ __attribute__((aligned(16))) unsigned char lds[];
#define HW_SLOT() ((int)__builtin_amdgcn_s_getreg((5 << 11) | 4) & 63)
#define TID() (64 * (int)__builtin_amdgcn_readfirstlane((int)((volatile LAS unsigned char*)((LAS unsigned char*)lds + MISC_OFF + 64))[HW_SLOT()]) + lane_id_now())
    { const int t0 = threadIdx.x; for (int u = t0; u < (LDS_BYTES - LDSCTL_OFF) / 4; u += NWAVES * 64) ((LAS unsigned*)((LAS unsigned char*)lds + LDSCTL_OFF))[u] = 0u; }
    __syncthreads();
    if ((threadIdx.x & 63) == 0) ((volatile LAS unsigned char*)((LAS unsigned char*)lds + MISC_OFF + 64))[HW_SLOT()] = (unsigned char)(threadIdx.x >> 6);
    __syncthreads();
#define MKF() Frame F; { int t_ = TID(); asm volatile("" : "+v"(t_)); F.lds = (LAS unsigned char*)lds; F.tid = t_; F.lane = t_ & 63; F.wave = __builtin_amdgcn_readfirstlane(t_ >> 6); \
        const int G_ = gridDim.x, bx_ = blockIdx.x; const int vcu_ = (G_ % 8 == 0) ? (bx_ % 8) * (G_ / 8) + bx_ / 8 : bx_; F.gw = vcu_ * NWAVES + F.wave; F.NGW = G_ * NWAVES; F.ws = args.ws; F.dout = (unsigned char*)args.out; }
    unsigned* ctl = (unsigned*)(args.ws + WS_CTL);
#if MK_ONE_LAUNCH
    (void)xcd_barrier_post(ctl + CW_BAR, (volatile LAS unsigned*)((LAS unsigned char*)lds + MISC_OFF) + 8, TID() == 0);
#define IN(k) true
#define SEAM(k) do { XcdBarrier b_; b_.bar = (unsigned*)(args.ws + WS_CTL) + CW_BAR; b_.x = xb_xcc_id(); b_.st = (volatile LAS unsigned*)((LAS unsigned char*)lds + MISC_OFF) + 8; xcd_barrier(b_, TID() == 0); } while (0)
#else
    const int lo = args.ph_lo, hi = args.ph_hi;
#define IN(k) (lo <= (k) && (k) < hi)
#define SEAM(k) do { } while (0)
#endif
#define HB ((bf16*)(args.ws + WS_H))
#define WSP(off) (args.ws + (off))
#define DOP(off) ((unsigned char*)args.out + (off))
#define LDSP ((LAS unsigned char*)lds + RING_OFF)
#define GRID_ ((int)gridDim.x)
    const float* const mod = (const float*)(args.ws + WS_MOD);
    float* const out = args.out;

    if (IN(0)) { MKF(); p0_mod_partials(F, args); p0_weights<0>(F, args); } SEAM(0);
    if (IN(1)) { MKF(); p1_mod_reduce(F, args); p0_weights<1>(F, args); } SEAM(1);
    if (IN(2)) { MKF(); p2_ln_mod(F, args); } SEAM(2);
    if (IN(3)) {
        { pg8::Gemm g{(const bf16*)(args.ws + WS_H8), (const bf16*)(args.ws + WS_W8), M, 9216, D}; pg8::StaticOrder S; S.init(M, 9216, GRID_, (int)blockIdx.x);
          pg8::EpiQKVF E{(bf16*)(args.ws + WS_Q), (bf16*)(args.ws + WS_K), (bf16*)(args.ws + WS_V), (bf16*)(args.ws + WS_F), (const float*)(args.ws + WS_ROPE), 0};
          pg8::gemm_phase<pg8::EpiQKVF, pg8::StaticOrder, true, true, true>(LDSP, g, S, E, TID()); }
        { pg8::Gemm g{HB, (const bf16*)(args.ws + WS_WF), M, 1024, D}; pg8::StaticOrder S; S.init(M, 1024, GRID_, ((int)blockIdx.x + GRID_ / 2) % GRID_);
          pg8::EpiQKVF E{(bf16*)(args.ws + WS_Q), (bf16*)(args.ws + WS_K), (bf16*)(args.ws + WS_V), (bf16*)(args.ws + WS_F), (const float*)(args.ws + WS_ROPE), 36};
          pg8::gemm_phase<pg8::EpiQKVF, pg8::StaticOrder, true, true>(LDSP, g, S, E, TID()); }
    } SEAM(3);
    if (IN(4)) {
        { MKF(); p_attention(F); }
        { pg8::Gemm g{(const bf16*)(args.ws + WS_C256), (const bf16*)(args.ws + WS_F), 512, 65536, 256}; pg8::DftOrder S; S.init(512, 65536, GRID_, (int)blockIdx.x); S.tsh = 6; S.gjump = (size_t)M * 512 - (size_t)64 * 1024; S.brow_bytes = 128 * 512;
          pg8::EpiA1 E{(bf16*)((unsigned char*)args.out + DO_A1), 6, 7, 0.0625f};
          pg8::gemm_phase<pg8::EpiA1, pg8::DftOrder, false, false>(LDSP, g, S, E, TID()); }
        { pg8::Gemm g{(const bf16*)(args.ws + WS_C256), (const bf16*)(args.ws + WS_F) + (size_t)S0 * 256, 512, 32768, 256}; pg8::DftOrder S; S.init(512, 32768, GRID_, (int)blockIdx.x); S.tsh = 5; S.gjump = (size_t)M * 512 - (size_t)32 * 1024; S.brow_bytes = 64 * 512;
          pg8::EpiA1 E{(bf16*)((unsigned char*)args.out + DO_A1) + (size_t)131072 * 256, 5, 6, 0.0625f};
          pg8::gemm_phase<pg8::EpiA1, pg8::DftOrder, false, false>(LDSP, g, S, E, TID()); }
    } SEAM(4);
    if (IN(6)) {
        { MKF(); p_combine(F); }
        { pg8::Gemm g{(const bf16*)(args.ws + WS_D128), (const bf16*)((unsigned char*)args.out + DO_A1), 256, 196608, 256}; pg8::StaticOrder S; S.init(256, 196608, GRID_, (int)blockIdx.x);
          pg8::EpiTwT E{(bf16*)((unsigned char*)args.out + DO_A2), 0.08838834764831845f, (const float*)(args.ws + WS_TW)};
          pg8::gemm_phase<pg8::EpiTwT, pg8::StaticOrder, false, false>(LDSP, g, S, E, TID()); }
    } SEAM(6);
    if (IN(7)) {
        { pg8::Gemm g{(const bf16*)(args.ws + WS_H8), (const bf16*)(args.ws + WS_W8 + (size_t)9216 * D), M, NGATE, D}; pg8::StaticOrder S; S.init(M, NGATE, GRID_, (int)blockIdx.x);
          pg8::EpiGates E{args.ws + WS_G};
          pg8::gemm_phase<pg8::EpiGates, pg8::StaticOrder, true, true, true>(LDSP, g, S, E, TID()); }
    }
    if (IN(8)) {
        { pg8::Gemm g{(const bf16*)((unsigned char*)args.out + DO_A2), (const bf16*)(args.ws + WS_D128), 131072, 256, 256}; pg8::StaticOrder S; S.init(131072, 256, GRID_, (int)blockIdx.x);
          pg8::EpiFour E{(bf16*)((unsigned char*)args.out + DO_FOUR), 0, 128, 0.08838834764831845f};
          pg8::gemm_phase<pg8::EpiFour, pg8::StaticOrder, true, false>(LDSP, g, S, E, TID()); }
        { pg8::Gemm g{(const bf16*)((unsigned char*)args.out + DO_A2) + (size_t)131072 * 256, (const bf16*)(args.ws + WS_D64), 131072, 256, 256}; pg8::StaticOrder S; S.init(131072, 256, GRID_, (int)blockIdx.x);
          pg8::EpiFour E{(bf16*)((unsigned char*)args.out + DO_FOUR), S0, 64, 0.125f};
          pg8::gemm_phase<pg8::EpiFour, pg8::StaticOrder, true, false>(LDSP, g, S, E, TID()); }
    } SEAM(8);
    if (IN(10)) {
        { pg8::Gemm g{(const bf16*)((unsigned char*)args.out + DO_ATTN), (const bf16*)(args.ws + WS_WAU), M, D, 1024, 0x78787878, 0x79797979}; pg8::StaticOrder S; S.init(M, D, GRID_, (int)blockIdx.x);
          pg8::EpiBranch<0> E{args.ws + WS_G, HB, args.ws + WS_MA};
          pg8::gemm_phase<pg8::EpiBranch<0>, pg8::StaticOrder, true, true, true>(LDSP, g, S, E, TID()); }
        { pg8::Gemm g{(const bf16*)((unsigned char*)args.out + DO_FOUR), (const bf16*)(args.ws + WS_WFU), M, D, 1024}; pg8::StaticOrder S; S.init(M, D, GRID_, (int)blockIdx.x);
          pg8::EpiBranch<1> E{args.ws + WS_G, HB, args.ws + WS_MA};
          pg8::gemm_phase<pg8::EpiBranch<1>, pg8::StaticOrder, true, true>(LDSP, g, S, E, TID()); }
    } SEAM(10);
    if (IN(11)) {
        pg8::Gemm g{HB, (const bf16*)(args.ws + WS_WMIX), M, D, D}; pg8::StaticOrder S; S.init(M, D, GRID_, (int)blockIdx.x);
        pg8::EpiContrib E{(bf16*)(args.ws + WS_C1), mod + 2 * D, mod + 6 * D + 2 * D};
        pg8::gemm_phase<pg8::EpiContrib, pg8::StaticOrder, true, true>(LDSP, g, S, E, TID());
    } SEAM(11);
    if (IN(12)) { MKF(); p13_ln1(F, args); } SEAM(12);
    if (IN(13)) {
        pg8::Gemm g{HB, (const bf16*)(args.ws + WS_WGU), M, NGU, D, 0x79797979, 0x7f7f7f7f}; pg8::StaticOrder S; S.init(M, NGU, GRID_, (int)blockIdx.x);
        pg8::EpiGU E{(unsigned char*)(args.ws + WS_HID)};
        pg8::gemm_phase<pg8::EpiGU, pg8::StaticOrder, true, true, true>(LDSP, g, S, E, TID());
    } SEAM(13);
    if (IN(14)) {
        pg8::Gemm g{(const bf16*)(args.ws + WS_HID), (const bf16*)(args.ws + WS_WD), M, D, FF, 0x78787878, 0x7b7b7b7b}; pg8::StaticOrder S; S.init(M, D, GRID_, (int)blockIdx.x);
        pg8::EpiContrib E{(bf16*)(args.ws + WS_C2), mod + 5 * D, mod + 6 * D + 5 * D};
        pg8::gemm_phase<pg8::EpiContrib, pg8::StaticOrder, true, true, true>(LDSP, g, S, E, TID());
    } SEAM(14);
    if (IN(15)) { MKF(); p16_ln2(F, args); }
#undef IN
#undef SEAM
}

extern "C" void kernel_launch(void* const* d_in, const int* in_sizes, int n_in, void* d_out, int out_size, void* d_ws, size_t ws_size, hipStream_t stream) {
    static int grid = 0;
    if (grid == 0) {
        if (n_in != 17 || out_size != M * D || ws_size < WS_END) { fprintf(stderr, "kernel_launch: unexpected shapes (n_in %d, out %d, ws %zu); nothing launched\n", n_in, out_size, ws_size); grid = -1; return; }
        int dev = 0, cus = 0;
        if (hipGetDevice(&dev) != hipSuccess || hipDeviceGetAttribute(&cus, hipDeviceAttributeMultiprocessorCount, dev) != hipSuccess) { grid = -1; return; }
        if (hipFuncSetAttribute((const void*)enc_fwd, hipFuncAttributeMaxDynamicSharedMemorySize, LDS_BYTES) != hipSuccess) { fprintf(stderr, "kernel_launch: hipFuncSetAttribute failed\n"); grid = -1; return; }
        int per_cu = 0;
        if (hipOccupancyMaxActiveBlocksPerMultiprocessor(&per_cu, (const void*)enc_fwd, NWAVES * 64, LDS_BYTES) != hipSuccess || per_cu < 1) fprintf(stderr, "kernel_launch: occupancy query reports %d\n", per_cu);
        (void)hipGetLastError();
        grid = cus;
    }
    if (grid < 0) return;
    if (hipMemsetAsync((char*)d_ws + WS_CTL, 0, CTL_ZERO_BYTES, stream) != hipSuccess) return;
    Args a{};
    for (int i = 0; i < 17; ++i) a.in[i] = (const float*)d_in[i];
    a.out = (float*)d_out; a.ws = (unsigned char*)d_ws;
#if MK_ONE_LAUNCH
    a.ph_lo = 0; a.ph_hi = NPHASES;
    hipLaunchKernelGGL(enc_fwd, dim3(grid), dim3(NWAVES * 64), LDS_BYTES, stream, a);
#else
    for (int p = 0; p < NPHASES; ++p) { a.ph_lo = p; a.ph_hi = p + 1; hipLaunchKernelGGL(enc_fwd, dim3(grid), dim3(NWAVES * 64), LDS_BYTES, stream, a); }
#endif
}
```
